# Optimizing an MI355X kernel written in HIP

```python
import math
import jax, jax.numpy as jnp
from jax import lax
import numpy as np

D_MODEL = 1024
BATCH = 8
SEQ = 4096
DEPTH = 4

N_MIXERS = 2
SSM_GROUP = 16
SSM_GROUPS = D_MODEL // SSM_GROUP
SSM_STATE = 64
CONV_WIDTH = 3
FFN_HIDDEN = ((8 * D_MODEL + 3 * 256 - 1) // (3 * 256)) * 256
N_SSM_LAYERS = (DEPTH + 1) // 2
N_CONV_LAYERS = DEPTH // 2
RMS_EPS = 1e-6
DT_MIN = 1e-3
DT_MAX = 1e-1

kernel_name = "hybrid_s5_shortconv_adaln"


def rms_norm(x, g):
    x32 = x.astype(jnp.float32)
    y = x32 * lax.rsqrt(jnp.mean(x32 * x32, axis=-1, keepdims=True) + RMS_EPS)
    return (y * g.astype(jnp.float32)).astype(x.dtype)


def modulate(h, shift, scale):
    return h * (1.0 + scale) + shift


def _ssm_combine(e1, e2):
    a1r, a1i, b1r, b1i = e1
    a2r, a2i, b2r, b2i = e2
    ar = a2r * a1r - a2i * a1i
    ai = a2r * a1i + a2i * a1r
    br = a2r * b1r - a2i * b1i + b2r
    bi = a2r * b1i + a2i * b1r + b2i
    return (ar, ai, br, bi)


def s5_mixer(h, a_re, a_im, log_step, b_re, b_im, c_re, c_im, d, w_out):
    bsz, seqlen, _ = h.shape
    f32 = jnp.float32
    u = h.astype(f32).reshape(bsz, seqlen, SSM_GROUPS, SSM_GROUP)
    lr = jnp.minimum(a_re.astype(f32), -1e-4)
    li = a_im.astype(f32)
    dt = jnp.exp(log_step.astype(f32))[:, None]
    mag = jnp.exp(lr * dt)
    abr = mag * jnp.cos(li * dt)
    abi = mag * jnp.sin(li * dt)
    den = lr * lr + li * li
    qr = ((abr - 1.0) * lr + abi * li) / den
    qi = (abi * lr - (abr - 1.0) * li) / den
    br, bim = b_re.astype(f32), b_im.astype(f32)
    bbar_re = qr[..., None] * br - qi[..., None] * bim
    bbar_im = qr[..., None] * bim + qi[..., None] * br
    bu_re = jnp.einsum('blgh,gph->blgp', u, bbar_re)
    bu_im = jnp.einsum('blgh,gph->blgp', u, bbar_im)
    a_r = jnp.broadcast_to(abr[None, None], (1, seqlen, SSM_GROUPS, SSM_STATE))
    a_i = jnp.broadcast_to(abi[None, None], (1, seqlen, SSM_GROUPS, SSM_STATE))
    _, _, xr, xi = lax.associative_scan(_ssm_combine, (a_r, a_i, bu_re, bu_im), axis=1)
    y = (jnp.einsum('ghp,blgp->blgh', c_re.astype(f32), xr)
         - jnp.einsum('ghp,blgp->blgh', c_im.astype(f32), xi))
    y = y.reshape(bsz, seqlen, D_MODEL) + d.astype(f32) * h.astype(f32)
    y = jax.nn.gelu(y).astype(h.dtype)
    val, gate = jnp.split(y @ w_out, 2, axis=-1)
    return val * jax.nn.sigmoid(gate)


def short_conv_mixer(h, w_in, conv_w, w_out):
    bg, cg, v = jnp.split(h @ w_in, 3, axis=-1)
    cv = cg * v
    conv = lax.conv_general_dilated(
        cv, conv_w[:, None, :].astype(cv.dtype), window_strides=(1,),
        padding=[(CONV_WIDTH - 1, 0)], dimension_numbers=('NWC', 'WIO', 'NWC'),
        feature_group_count=D_MODEL)
    return (bg * conv) @ w_out


def swiglu(h, w_in, w_out):
    g, u = jnp.split(h @ w_in, 2, axis=-1)
    return (jax.nn.silu(g) * u) @ w_out


def setup_inputs(seed: int = 0) -> dict:
    key = jax.random.key(seed)
    ks = jax.random.split(key, 24)
    D, G, P, H, F = D_MODEL, SSM_GROUPS, SSM_STATE, SSM_GROUP, FFN_HIDDEN
    nrm = jax.random.normal
    x = nrm(ks[0], (BATCH, SEQ, D), jnp.float32)
    c = nrm(ks[1], (BATCH, D), jnp.float32)
    norm1_g = 1.0 + 0.02 * nrm(ks[2], (DEPTH, D), jnp.float32)
    norm2_g = 1.0 + 0.02 * nrm(ks[3], (DEPTH, D), jnp.float32)
    w_ada = 0.5 * D ** -0.5 * nrm(ks[4], (DEPTH, D, 6 * D), jnp.float32)
    b_ada = 0.01 * nrm(ks[5], (DEPTH, 6 * D), jnp.float32)
    n_idx = jnp.arange(P, dtype=jnp.float32)
    ssm_a_re = -0.5 + 0.01 * nrm(ks[6], (N_SSM_LAYERS, G, P), jnp.float32)
    ssm_a_im = math.pi * n_idx + 0.01 * nrm(ks[7], (N_SSM_LAYERS, G, P), jnp.float32)
    ssm_log_step = jax.random.uniform(ks[8], (N_SSM_LAYERS, G), jnp.float32,
                                      math.log(DT_MIN), math.log(DT_MAX))
    ssm_b_re = (2 * H) ** -0.5 * nrm(ks[9], (N_SSM_LAYERS, G, P, H), jnp.float32)
    ssm_b_im = (2 * H) ** -0.5 * nrm(ks[10], (N_SSM_LAYERS, G, P, H), jnp.float32)
    ssm_c_re = (2 * P) ** -0.5 * nrm(ks[11], (N_SSM_LAYERS, G, H, P), jnp.float32)
    ssm_c_im = (2 * P) ** -0.5 * nrm(ks[12], (N_SSM_LAYERS, G, H, P), jnp.float32)
    ssm_d = nrm(ks[13], (N_SSM_LAYERS, D), jnp.float32)
    ssm_w_out = D ** -0.5 * nrm(ks[14], (N_SSM_LAYERS, D, 2 * D), jnp.float32)
    conv_w_in = D ** -0.5 * nrm(ks[15], (N_CONV_LAYERS, D, 3 * D), jnp.float32)
    conv_w = CONV_WIDTH ** -0.5 * nrm(ks[16], (N_CONV_LAYERS, CONV_WIDTH, D), jnp.float32)
    conv_w_out = D ** -0.5 * nrm(ks[17], (N_CONV_LAYERS, D, D), jnp.float32)
    w_ffn_in = D ** -0.5 * nrm(ks[18], (DEPTH, D, 2 * F), jnp.float32)
    w_ffn_out = F ** -0.5 * nrm(ks[19], (DEPTH, F, D), jnp.float32)
    final_g = 1.0 + 0.02 * nrm(ks[20], (D,), jnp.float32)
    return {"x": x, "c": c, "norm1_g": norm1_g, "norm2_g": norm2_g,
            "w_ada": w_ada, "b_ada": b_ada,
            "ssm_a_re": ssm_a_re, "ssm_a_im": ssm_a_im, "ssm_log_step": ssm_log_step,
            "ssm_b_re": ssm_b_re, "ssm_b_im": ssm_b_im,
            "ssm_c_re": ssm_c_re, "ssm_c_im": ssm_c_im,
            "ssm_d": ssm_d, "ssm_w_out": ssm_w_out,
            "conv_w_in": conv_w_in, "conv_w": conv_w, "conv_w_out": conv_w_out,
            "w_ffn_in": w_ffn_in, "w_ffn_out": w_ffn_out, "final_g": final_g}


def reference(x, c, norm1_g, norm2_g, w_ada, b_ada,
              ssm_a_re, ssm_a_im, ssm_log_step, ssm_b_re, ssm_b_im,
              ssm_c_re, ssm_c_im, ssm_d, ssm_w_out,
              conv_w_in, conv_w, conv_w_out,
              w_ffn_in, w_ffn_out, final_g):
    c_act = jax.nn.silu(c)
    for i in range(DEPTH):
        mods = c_act @ w_ada[i] + b_ada[i]
        sh1, sc1, g1, sh2, sc2, g2 = [m[:, None, :] for m in jnp.split(mods, 6, axis=-1)]
        h = modulate(rms_norm(x, norm1_g[i]), sh1, sc1)
        j = i // N_MIXERS
        if i % N_MIXERS == 0:
            mix = s5_mixer(h, ssm_a_re[j], ssm_a_im[j], ssm_log_step[j],
                           ssm_b_re[j], ssm_b_im[j], ssm_c_re[j], ssm_c_im[j],
                           ssm_d[j], ssm_w_out[j])
        else:
            mix = short_conv_mixer(h, conv_w_in[j], conv_w[j], conv_w_out[j])
        x = x + g1 * mix
        h = modulate(rms_norm(x, norm2_g[i]), sh2, sc2)
        x = x + g2 * swiglu(h, w_ffn_in[i], w_ffn_out[i])
    return rms_norm(x, final_g)
```

```cpp
#include <hip/hip_runtime.h>
#include <hip/hip_cooperative_groups.h>
#include <cstdint>
#include <cstdio>
namespace cg = cooperative_groups;

constexpr int Dm = 1024, NB = 8, SEQ = 4096, MT = NB * SEQ, FF = 2816;

__device__ __forceinline__ float sigm(float x) { return __builtin_amdgcn_rcpf(1.f + __expf(-x)); }
__device__ __forceinline__ float gelu_tanh(float y) {
    const float z = 0.7978845608028654f * (y + 0.044715f * y * y * y);
    return y * sigm(2.f * z);
}
__device__ __forceinline__ void sincos_d(double x, double& s, double& c) {
    const double q = rint(x * 0.63661977236758134308);
    double r = fma(-q, 1.57079632673412561417e+00, x);
    r = fma(-q, 6.07710050650619224932e-11, r);
    r = fma(-q, 2.02226624879595063154e-21, r);
    const double z = r * r;
    const double sp = r + r * z * (-1.66666666666666324348e-01 + z * (8.33333333332248946124e-03 + z * (-1.98412698298579493134e-04 + z * (2.75573137070700676789e-06 + z * (-2.50507602534068634195e-08 + z * 1.58969099521155010221e-10)))));
    const double cp = 1.0 - 0.5 * z + z * z * (4.16666666666666019037e-02 + z * (-1.38888888888741095749e-03 + z * (2.48015872894767294178e-05 + z * (-2.75573143513906633035e-07 + z * (2.08757232129817482790e-09 + z * -1.13596475577881948265e-11)))));
    const int qi = ((int)q) & 3;
    s = (qi == 0) ? sp : (qi == 1) ? cp : (qi == 2) ? -sp : -cp;
    c = (qi == 0) ? cp : (qi == 1) ? -sp : (qi == 2) ? -cp : sp;
}
struct SsmP { double abr, abi, qr, qi; };
__device__ __forceinline__ SsmP ssm_param(float a_re, float a_im, float log_step) {
    const double lr = fmin((double)a_re, -1e-4), li = (double)a_im, dt = exp((double)log_step);
    const double mag = exp(lr * dt);
    double sn, cs; sincos_d(li * dt, sn, cs);
    SsmP p; p.abr = mag * cs; p.abi = mag * sn;
    const double den = lr * lr + li * li;
    p.qr = ((p.abr - 1.0) * lr + p.abi * li) / den;
    p.qi = (p.abi * lr - (p.abr - 1.0) * li) / den;
    return p;
}
namespace pg8 {
#define PG8_LAS __attribute__((address_space(3)))
typedef unsigned short bf16_t;
typedef short bf16x8 __attribute__((ext_vector_type(8)));
typedef float f32x4 __attribute__((ext_vector_type(4)));
typedef unsigned u32x4 __attribute__((ext_vector_type(4)));
constexpr int BM = 256, BK = 64, HALF = 128, HTB = HALF * BK * 2  , STAGE_BYTES = 8 * HTB, NXCD = 8, WGM = 8;

__host__ __device__ __forceinline__ int lds_byte(int r, int c) { const int st = (r >> 4) * 2 + (c >> 5), rr = r & 15, cc = c & 31, ob = rr * 64 + cc * 2; return st * 1024 + (ob ^ (((ob >> 9) & 1) << 5)); }
__host__ __device__ __forceinline__ void stage_rc(int b, int& R, int& C) { const int st = b / 1024, sb = b % 1024, swz = sb ^ (((sb >> 9) & 1) << 5); R = (st >> 1) * 16 + swz / 64; C = (st & 1) * 32 + (swz % 64) / 2; }
__host__ __device__ __forceinline__ int perm32(int rho) { const int n = rho >> 4, i = rho & 15; return 8 * (i >> 2) + 4 * n + (i & 3); }

struct Unit { int pm, pn, ord; };
struct Gemm { const bf16_t* A; const bf16_t* Bt; int M, N, K; };

struct StaticOrder {
    int nM, nN, nwg, G, c;
    __host__ __device__ void init(int M, int N, int G_, int c_) { nM = M / BM; nN = N / BM; nwg = nM * nN; G = G_; c = c_; }
    __host__ __device__ bool next(int i, Unit& u) const {
        const long L = (long)i * G + c; if (L >= nwg) return false;
        int wgid = (int)L; { const int q = nwg / NXCD, r = nwg % NXCD, xcd = wgid % NXCD, off = wgid / NXCD; wgid = (xcd < r ? xcd * (q + 1) : r * (q + 1) + (xcd - r) * q) + off; }
        const int nig = WGM * nN, gid = wgid / nig, fm = gid * WGM, gsz = (nM - fm) < WGM ? (nM - fm) : WGM;
        u.pm = fm + ((wgid % nig) % gsz); u.pn = (wgid % nig) / gsz; u.ord = i; return true;
    }
    __device__ __forceinline__ void a_ready(const Unit&) const {}
    __device__ __forceinline__ void done(const Unit&) const {}
};

__device__ __forceinline__ unsigned cvt_pk_bf16(float lo, float hi) { unsigned r; asm volatile("v_cvt_pk_bf16_f32 %0, %1, %2" : "=v"(r) : "v"(lo), "v"(hi)); return r; }

__device__ __forceinline__ float sigm_(float x) { return __builtin_amdgcn_rcpf(1.f + __expf(-x)); }
template <int NS> __device__ __forceinline__ void phase_rstd(PG8_LAS float* rl, const float* slots, const StaticOrder& S) {
    int tid = threadIdx.x; asm volatile("" : "+v"(tid));
    const int nu = (S.nwg - S.c + S.G - 1) / S.G, row = tid & 255;
#pragma unroll 3
    for (int i = tid >> 8; i < nu; i += 2) {
        Unit u; S.next(i, u);
        const f32x4* p = (const f32x4*)(slots + (size_t)(u.pm * BM + row) * 32);
        f32x4 v[NS / 4];
#pragma unroll
        for (int q = 0; q < NS / 4; ++q) v[q] = p[q];
        float s = 0.f;
#pragma unroll
        for (int q = 0; q < NS / 4; ++q) s += (v[q][0] + v[q][1]) + (v[q][2] + v[q][3]);
        rl[i * 256 + row] = rsqrtf(s * (1.f / 1024.f) + 1e-6f);
    }
    __syncthreads();
}
__device__ __forceinline__ u32x4 pack8(const f32x4& a, const f32x4& b) {
    u32x4 w; w.x = cvt_pk_bf16(a[0], a[1]); w.y = cvt_pk_bf16(a[2], a[3]); w.z = cvt_pk_bf16(b[0], b[1]); w.w = cvt_pk_bf16(b[2], b[3]); return w;
}

template <int NS> struct EpiF1 {
    static constexpr bool PERM = true, AFTER_DRAIN = false;
    bf16_t* act; const float* bias; const float* slots; PG8_LAS float* rl;
    __device__ __forceinline__ void operator()(const f32x4 (&acc)[2][2][4][2], const Unit& u, int wr, int wc, int fr, int fq) const {
        asm volatile("" : "+v"(fr), "+v"(fq));
        const int row0 = u.pm * BM, b = u.pm >> 4, cl = wc * 32 + 8 * fq;
        const float* bp = bias + (size_t)b * 5632 + u.pn * 256 + cl;
        const f32x4 bg0 = *(const f32x4*)(bp), bg1 = *(const f32x4*)(bp + 4), bu0 = *(const f32x4*)(bp + 128), bu1 = *(const f32x4*)(bp + 132);
        const f32x4 bgn0 = bg0 * -1.4426950408889634f, bgn1 = bg1 * -1.4426950408889634f, bun0 = bu0 * -0.6931471805599453f, bun1 = bu1 * -0.6931471805599453f;
#pragma unroll
        for (int ai = 0; ai < 2; ++ai)
#pragma unroll
            for (int m = 0; m < 4; ++m) {
                const int rloc = ai * HALF + wr * 64 + m * 16 + fr; const float rs = rl[u.ord * 256 + rloc], rsn = rs * -1.4426950408889634f, rsu = rs * -0.6931471805599453f;
                const f32x4 n0 = acc[ai][0][m][0] * rsn + bgn0, n1 = acc[ai][0][m][1] * rsn + bgn1, u0 = acc[ai][1][m][0] * rsu + bun0, u1 = acc[ai][1][m][1] * rsu + bun1;
                f32x4 e0, e1;
#pragma unroll
                for (int j = 0; j < 4; ++j) { e0[j] = __builtin_amdgcn_exp2f(n0[j]); e1[j] = __builtin_amdgcn_exp2f(n1[j]); }
                e0 = e0 + 1.f; e1 = e1 + 1.f;
                f32x4 r0, r1;
#pragma unroll
                for (int j = 0; j < 4; ++j) { r0[j] = __builtin_amdgcn_rcpf(e0[j]); r1[j] = __builtin_amdgcn_rcpf(e1[j]); }
                const f32x4 o0 = (n0 * u0) * r0, o1 = (n1 * u1) * r1;
                *(u32x4*)(act + (size_t)(row0 + rloc) * 2816 + u.pn * 128 + cl) = pack8(o0, o1);
            }
    }
};

__device__ __forceinline__ void unpack8(const u32x4& w, f32x4& a, f32x4& b) {
    a[0] = __builtin_bit_cast(float, w.x << 16); a[1] = __builtin_bit_cast(float, w.x & 0xffff0000u); a[2] = __builtin_bit_cast(float, w.y << 16); a[3] = __builtin_bit_cast(float, w.y & 0xffff0000u);
    b[0] = __builtin_bit_cast(float, w.z << 16); b[1] = __builtin_bit_cast(float, w.z & 0xffff0000u); b[2] = __builtin_bit_cast(float, w.w << 16); b[3] = __builtin_bit_cast(float, w.w & 0xffff0000u);
}
template <bool XF32> struct EpiGluRes {
    static constexpr bool PERM = true, AFTER_DRAIN = false;
    const float* xin; const bf16_t* xbin; bf16_t* xb; bf16_t* xs; const float* gate_v; const float* gsg; const float* gsc; float* slots;
    __device__ __forceinline__ void operator()(const f32x4 (&acc)[2][2][4][2], const Unit& u, int wr, int wc, int fr, int fq) const {
        asm volatile("" : "+v"(fr), "+v"(fq));
        const int row0 = u.pm * BM, b = u.pm >> 4, col = u.pn * 128 + wc * 32 + 8 * fq;
        const f32x4 gt0 = *(const f32x4*)(gate_v + (size_t)b * 6144 + col), gt1 = *(const f32x4*)(gate_v + (size_t)b * 6144 + col + 4);
        const f32x4 gs0 = *(const f32x4*)(gsg + col) * (*(const f32x4*)(gsc + (size_t)b * 6144 + col) + 1.f);
        const f32x4 gs1 = *(const f32x4*)(gsg + col + 4) * (*(const f32x4*)(gsc + (size_t)b * 6144 + col + 4) + 1.f);
#pragma unroll
        for (int ai = 0; ai < 2; ++ai) {
            f32x4 xf[4][2]; u32x4 xv[4];
#pragma unroll
            for (int m = 0; m < 4; ++m) {
                const size_t row = (size_t)(row0 + ai * HALF + wr * 64 + m * 16 + fr);
                if (XF32) { xf[m][0] = *(const f32x4*)(xin + row * 1024 + col); xf[m][1] = *(const f32x4*)(xin + row * 1024 + col + 4); }
                else xv[m] = *(const u32x4*)(xbin + row * 1024 + col);
            }
#pragma unroll
            for (int m = 0; m < 4; ++m) {
                const size_t row = (size_t)(row0 + ai * HALF + wr * 64 + m * 16 + fr);
                f32x4 x0, x1;
                if (XF32) { x0 = xf[m][0]; x1 = xf[m][1]; } else unpack8(xv[m], x0, x1);
                const f32x4 a0 = acc[ai][1][m][0] * -1.4426950408889634f, a1 = acc[ai][1][m][1] * -1.4426950408889634f;
                f32x4 e0, e1;
#pragma unroll
                for (int j = 0; j < 4; ++j) { e0[j] = __builtin_amdgcn_exp2f(a0[j]); e1[j] = __builtin_amdgcn_exp2f(a1[j]); }
                e0 = e0 + 1.f; e1 = e1 + 1.f;
                f32x4 r0, r1;
#pragma unroll
                for (int j = 0; j < 4; ++j) { r0[j] = __builtin_amdgcn_rcpf(e0[j]); r1[j] = __builtin_amdgcn_rcpf(e1[j]); }
                const f32x4 n0 = x0 + gt0 * (acc[ai][0][m][0] * r0), n1 = x1 + gt1 * (acc[ai][0][m][1] * r1);
                *(u32x4*)(xb + row * 1024 + col) = pack8(n0, n1);
                *(u32x4*)(xs + row * 1024 + col) = pack8(n0 * gs0, n1 * gs1);
                float ss = ((n0[0] * n0[0] + n0[1] * n0[1]) + (n0[2] * n0[2] + n0[3] * n0[3])) + ((n1[0] * n1[0] + n1[1] * n1[1]) + (n1[2] * n1[2] + n1[3] * n1[3]));
                ss += __shfl_xor(ss, 16); ss += __shfl_xor(ss, 32);
                if (fq == 0) slots[row * 32 + u.pn * 4 + wc] = ss;
            }
        }
    }
};

template <bool LAST> struct EpiRes {
    static constexpr bool PERM = true, AFTER_DRAIN = false;
    const bf16_t* xbin; bf16_t* xb; float* xout; bf16_t* xs; const float* gate_v; const float* gsg; const float* gsc; float* slots;
    __device__ __forceinline__ void operator()(const f32x4 (&acc)[2][2][4][2], const Unit& u, int wr, int wc, int fr, int fq) const {
        asm volatile("" : "+v"(fr), "+v"(fq));
        const int row0 = u.pm * BM, b = u.pm >> 4, col = u.pn * 256 + wc * 32 + 8 * fq;
        f32x4 gt[2][2], gs[2][2];
#pragma unroll
        for (int bj = 0; bj < 2; ++bj)
#pragma unroll
            for (int n = 0; n < 2; ++n) {
                const int c = col + bj * HALF + 4 * n;
                gt[bj][n] = *(const f32x4*)(gate_v + (size_t)b * 6144 + c);
                if (!LAST) gs[bj][n] = *(const f32x4*)(gsg + c) * (*(const f32x4*)(gsc + (size_t)b * 6144 + c) + 1.f);
            }
#pragma unroll
        for (int ai = 0; ai < 2; ++ai) {
            u32x4 xv[4][2];
#pragma unroll
            for (int m = 0; m < 4; ++m)
#pragma unroll
                for (int bj = 0; bj < 2; ++bj) xv[m][bj] = *(const u32x4*)(xbin + (size_t)(row0 + ai * HALF + wr * 64 + m * 16 + fr) * 1024 + col + bj * HALF);
#pragma unroll
            for (int m = 0; m < 4; ++m) {
                const size_t row = (size_t)(row0 + ai * HALF + wr * 64 + m * 16 + fr);
                float ss = 0.f;
#pragma unroll
                for (int bj = 0; bj < 2; ++bj) {
                    const size_t o = row * 1024 + col + bj * HALF;
                    f32x4 x0, x1; unpack8(xv[m][bj], x0, x1);
                    const f32x4 n0 = x0 + gt[bj][0] * acc[ai][bj][m][0], n1 = x1 + gt[bj][1] * acc[ai][bj][m][1];
                    if (LAST) { *(f32x4*)(xout + o) = n0; *(f32x4*)(xout + o + 4) = n1; }
                    else { *(u32x4*)(xb + o) = pack8(n0, n1); *(u32x4*)(xs + o) = pack8(n0 * gs[bj][0], n1 * gs[bj][1]); }
                    ss += ((n0[0] * n0[0] + n0[1] * n0[1]) + (n0[2] * n0[2] + n0[3] * n0[3])) + ((n1[0] * n1[0] + n1[1] * n1[1]) + (n1[2] * n1[2] + n1[3] * n1[3]));
                }
                ss += __shfl_xor(ss, 16); ss += __shfl_xor(ss, 32);
                if (fq == 0) slots[row * 32 + u.pn * 4 + wc] = ss;
            }
        }
    }
};

struct EpiCV {
    static constexpr bool PERM = true, AFTER_DRAIN = false;
    bf16_t* cv; const float* bias; PG8_LAS float* rl;
    __device__ __forceinline__ void operator()(const f32x4 (&acc)[2][2][4][2], const Unit& u, int wr, int wc, int fr, int fq) const {
        asm volatile("" : "+v"(fr), "+v"(fq));
        const int row0 = u.pm * BM, b = u.pm >> 4, cl = wc * 32 + 8 * fq;
        const float* bp = bias + (size_t)b * 3072 + u.pn * 256 + cl;
        const f32x4 b00 = *(const f32x4*)(bp), b01 = *(const f32x4*)(bp + 4), b10 = *(const f32x4*)(bp + 128), b11 = *(const f32x4*)(bp + 132);
#pragma unroll
        for (int ai = 0; ai < 2; ++ai)
#pragma unroll
            for (int m = 0; m < 4; ++m) {
                const int rloc = ai * HALF + wr * 64 + m * 16 + fr; const float rs = rl[u.ord * 256 + rloc];
                const f32x4 v00 = acc[ai][0][m][0] * rs + b00, v01 = acc[ai][0][m][1] * rs + b01, v10 = acc[ai][1][m][0] * rs + b10, v11 = acc[ai][1][m][1] * rs + b11;
                *(u32x4*)(cv + (size_t)(row0 + rloc) * 1024 + u.pn * 128 + cl) = pack8(v00 * v10, v01 * v11);
            }
    }
};
struct EpiBGP {
    static constexpr bool PERM = true, AFTER_DRAIN = false;
    const bf16_t* cv; bf16_t* p; const float* bias; const float* cw; PG8_LAS float* rl;
    __device__ __forceinline__ void operator()(const f32x4 (&acc)[2][2][4][2], const Unit& u, int wr, int wc, int fr, int fq) const {
        asm volatile("" : "+v"(fr), "+v"(fq));
        const int row0 = u.pm * BM, b = u.pm >> 4;
#pragma unroll
        for (int bj = 0; bj < 2; ++bj) {
            const int col = u.pn * 256 + bj * HALF + wc * 32 + 8 * fq;
            const float* bp = bias + (size_t)b * 3072 + 2048 + col;
            const f32x4 bb0 = *(const f32x4*)(bp), bb1 = *(const f32x4*)(bp + 4);
            const f32x4 w00 = *(const f32x4*)(cw + col), w01 = *(const f32x4*)(cw + col + 4), w10 = *(const f32x4*)(cw + 1024 + col), w11 = *(const f32x4*)(cw + 1024 + col + 4),
                        w20 = *(const f32x4*)(cw + 2048 + col), w21 = *(const f32x4*)(cw + 2048 + col + 4);
#pragma unroll
            for (int ah = 0; ah < 4; ++ah) {
                const int ai = ah >> 1, mb = (ah & 1) * 2;
                u32x4 q[2][3];
#pragma unroll
                for (int mm = 0; mm < 2; ++mm) {
                    const size_t row = (size_t)(row0 + ai * HALF + wr * 64 + (mb + mm) * 16 + fr); const int t = (int)(row & 4095);
                    const bf16_t* cp = cv + row * 1024 + col;
                    const u32x4 z = {0u, 0u, 0u, 0u};
                    q[mm][0] = *(const u32x4*)(cp); q[mm][1] = (t >= 1) ? *(const u32x4*)(cp - 1024) : z; q[mm][2] = (t >= 2) ? *(const u32x4*)(cp - 2048) : z;
                }
#pragma unroll
                for (int mm = 0; mm < 2; ++mm) {
                    const int m = mb + mm;
                    const int rloc = ai * HALF + wr * 64 + m * 16 + fr; const float rs = rl[u.ord * 256 + rloc];
                    const size_t row = (size_t)(row0 + rloc);
                    f32x4 c00, c01, c10, c11, c20, c21; unpack8(q[mm][0], c00, c01); unpack8(q[mm][1], c10, c11); unpack8(q[mm][2], c20, c21);
                    const f32x4 g0 = acc[ai][bj][m][0] * rs + bb0, g1 = acc[ai][bj][m][1] * rs + bb1;
                    const f32x4 cv0 = w20 * c00 + w10 * c10 + w00 * c20, cv1 = w21 * c01 + w11 * c11 + w01 * c21;
                    *(u32x4*)(p + row * 1024 + col) = pack8(g0 * cv0, g1 * cv1);
                }
            }
        }
    }
};

struct EpiNull {
    static constexpr bool PERM = true, AFTER_DRAIN = false;
    float* sink;
    __device__ __forceinline__ void operator()(const f32x4 (&acc)[2][2][4][2], const Unit& u, int wr, int wc, int fr, int fq) const {
        float s = 0.f;
#pragma unroll
        for (int ai = 0; ai < 2; ++ai)
#pragma unroll
            for (int bj = 0; bj < 2; ++bj)
#pragma unroll
                for (int m = 0; m < 4; ++m)
#pragma unroll
                    for (int n = 0; n < 2; ++n) s += (acc[ai][bj][m][n][0] + acc[ai][bj][m][n][1]) + (acc[ai][bj][m][n][2] + acc[ai][bj][m][n][3]);
        if (s == 1.2345e30f) sink[0] = s;
    }
};
template <class Epi, class Sched, bool ALIGN_EPI = false, bool SP2 = false>
__device__ __forceinline__ void gemm_phase(PG8_LAS unsigned char* lds, const Gemm g, const Sched& S, const Epi& E) {
    int tid_ = threadIdx.x; asm volatile("" : "+v"(tid_));
    const int tid = tid_, wid = __builtin_amdgcn_readfirstlane(tid >> 6), lane = tid & 63, wr = wid >> 2, wc = wid & 3, fr = lane & 15, fq = lane >> 4;
    const int K = g.K, nt = K / BK;
    unsigned voffA[2], voffB[2];
#pragma unroll
    for (int i = 0; i < 2; ++i) { int R, C; stage_rc(tid * 16 + i * 8192, R, C); const int Rb = Epi::PERM ? ((R & ~31) + perm32(R & 31)) : R;
        voffA[i] = (unsigned)(R * K + C) * 2u; voffB[i] = (unsigned)(Rb * K + C) * 2u; }
    const size_t kstep = (size_t)(BK * 2);
    const size_t hstep = (size_t)HALF * K * 2;
    const size_t tstep = 2 * hstep;
    const unsigned ldsw = (unsigned)wid * 1024u;
    const int aoff = lds_byte(wr * 64 + fr, fq * 8), boff = lds_byte(wc * 32 + fr, fq * 8);
#define PG8_SA(b, h) (((b) * 2 + (h)) * HTB)
#define PG8_SB(b, h) ((4 + (b) * 2 + (h)) * HTB)
#define PG8_STAGE(bufoff, gbase, voff) do { _Pragma("unroll") for (int _i = 0; _i < 2; ++_i) \
        __builtin_amdgcn_global_load_lds((const unsigned*)((const char*)(gbase) + (voff)[_i]), (PG8_LAS unsigned*)(lds + (bufoff) + ldsw + _i * 8192), 16, 0, 0); } while (0)
#define PG8_LDA(dst, b, h) do { _Pragma("unroll") for (int m = 0; m < 4; ++m) _Pragma("unroll") for (int k = 0; k < 2; ++k) dst[m][k] = *(const PG8_LAS bf16x8*)(lds + PG8_SA(b, h) + aoff + m * 2048 + k * 1024); } while (0)
#define PG8_LDB(dst, b, h) do { _Pragma("unroll") for (int n = 0; n < 2; ++n) _Pragma("unroll") for (int k = 0; k < 2; ++k) dst[n][k] = *(const PG8_LAS bf16x8*)(lds + PG8_SB(b, h) + boff + n * 2048 + k * 1024); } while (0)
#define PG8_MMA(ai, bj, At, Bt) do { __builtin_amdgcn_s_setprio(1); _Pragma("unroll") for (int m = 0; m < 4; ++m) _Pragma("unroll") for (int n = 0; n < 2; ++n) _Pragma("unroll") for (int k = 0; k < 2; ++k) \
        acc[ai][bj][m][n] = __builtin_amdgcn_mfma_f32_16x16x32_bf16(Bt[n][k], At[m][k], acc[ai][bj][m][n], 0, 0, 0); __builtin_amdgcn_s_setprio(0); } while (0)
#define PG8_WAIT_V(n) asm volatile("s_waitcnt vmcnt(" #n ")" ::: "memory")
#define PG8_WAIT_L(n) asm volatile("s_waitcnt lgkmcnt(" #n ")" ::: "memory")
#define PG8_BAR __builtin_amdgcn_s_barrier()
#define PG8_SCHED __builtin_amdgcn_sched_barrier(0)
    Unit cur, nxt; int ui = 0;
    if (!S.next(0, cur)) return;
    f32x4 acc[2][2][4][2];
#pragma unroll
    for (int a = 0; a < 2; ++a)
#pragma unroll
        for (int b = 0; b < 2; ++b)
#pragma unroll
            for (int m = 0; m < 4; ++m)
#pragma unroll
                for (int n = 0; n < 2; ++n) acc[a][b][m][n] = (f32x4){0.f, 0.f, 0.f, 0.f};
    bf16x8 At[4][2], B0[2][2], B1[2][2];
    const char* cA = (const char*)g.A + (size_t)cur.pm * tstep; const char* cB = (const char*)g.Bt + (size_t)cur.pn * tstep;
    S.a_ready(cur);
    if constexpr (SP2) {
        PG8_STAGE(PG8_SB(0, 0), cB, voffB); PG8_STAGE(PG8_SB(0, 1), cB + hstep, voffB); PG8_STAGE(PG8_SA(0, 0), cA, voffA); PG8_STAGE(PG8_SA(0, 1), cA + hstep, voffA);
        if (wr == 1) PG8_BAR;
        PG8_WAIT_V(2); PG8_BAR;
        PG8_STAGE(PG8_SB(1, 0), cB + kstep, voffB); PG8_STAGE(PG8_SA(1, 0), cA + kstep, voffA); PG8_STAGE(PG8_SB(1, 1), cB + hstep + kstep, voffB);
        PG8_WAIT_V(6); PG8_BAR;
    } else {
        PG8_STAGE(PG8_SB(0, 0), cB, voffB); PG8_STAGE(PG8_SA(0, 0), cA, voffA); PG8_STAGE(PG8_SB(0, 1), cB + hstep, voffB); PG8_STAGE(PG8_SA(0, 1), cA + hstep, voffA);
        if (wr == 1) PG8_BAR;
        PG8_WAIT_V(4); PG8_BAR;
        PG8_STAGE(PG8_SB(1, 0), cB + kstep, voffB); PG8_STAGE(PG8_SA(1, 0), cA + kstep, voffA); PG8_STAGE(PG8_SB(1, 1), cB + hstep + kstep, voffB);
        PG8_WAIT_V(6); PG8_BAR;
    }
    for (;;) {
        const bool has_next = S.next(ui + 1, nxt);
        const char* nA = has_next ? (const char*)g.A + (size_t)nxt.pm * tstep : cA; const char* nB = has_next ? (const char*)g.Bt + (size_t)nxt.pn * tstep : cB;
        for (int t = 0; t < nt; t += 2) {
            const bool last = (t == nt - 2);
            const char* a1 = cA + (size_t)(t + 1) * kstep;
            const char* a2 = last ? nA : cA + (size_t)(t + 2) * kstep; const char* b2 = last ? nB : cB + (size_t)(t + 2) * kstep;
            const char* a3 = a2 + kstep; const char* b3 = b2 + kstep;
            if (last && has_next) S.a_ready(nxt);
            if constexpr (SP2) {
            PG8_LDB(B0, 0, 0); PG8_LDB(B1, 0, 1); PG8_SCHED; PG8_LDA(At, 0, 0); PG8_STAGE(PG8_SA(1, 1), a1 + hstep, voffA);
            PG8_WAIT_V(8); PG8_WAIT_L(0); PG8_BAR; PG8_MMA(0, 0, At, B0); PG8_MMA(0, 1, At, B1); PG8_BAR; PG8_SCHED;
            PG8_LDA(At, 0, 1); PG8_STAGE(PG8_SB(0, 0), b2, voffB); PG8_STAGE(PG8_SB(0, 1), b2 + hstep, voffB); PG8_STAGE(PG8_SA(0, 0), a2, voffA);
            PG8_WAIT_V(8); PG8_WAIT_L(0); PG8_BAR; PG8_MMA(1, 0, At, B0); PG8_MMA(1, 1, At, B1); PG8_BAR; PG8_SCHED;
            PG8_LDB(B0, 1, 0); PG8_LDB(B1, 1, 1); PG8_SCHED; PG8_LDA(At, 1, 0); PG8_STAGE(PG8_SA(0, 1), a2 + hstep, voffA);
            PG8_WAIT_V(8); PG8_WAIT_L(0); PG8_BAR; PG8_MMA(0, 0, At, B0); PG8_MMA(0, 1, At, B1); PG8_BAR; PG8_SCHED;
            PG8_LDA(At, 1, 1); PG8_STAGE(PG8_SB(1, 0), b3, voffB); PG8_STAGE(PG8_SB(1, 1), b3 + hstep, voffB); PG8_STAGE(PG8_SA(1, 0), a3, voffA);
            PG8_WAIT_V(8); PG8_WAIT_L(0); PG8_BAR; PG8_MMA(1, 0, At, B0); PG8_MMA(1, 1, At, B1); PG8_BAR; PG8_SCHED;
            } else {
            PG8_LDB(B0, 0, 0); PG8_SCHED; PG8_LDA(At, 0, 0); PG8_STAGE(PG8_SA(1, 1), a1 + hstep, voffA);
            PG8_WAIT_L(8); PG8_BAR; PG8_WAIT_L(0); PG8_MMA(0, 0, At, B0); PG8_BAR; PG8_SCHED;
            PG8_LDB(B1, 0, 1); PG8_STAGE(PG8_SB(0, 0), b2, voffB);
            PG8_BAR; PG8_WAIT_L(0); PG8_MMA(0, 1, At, B1); PG8_BAR;
            PG8_LDA(At, 0, 1); PG8_STAGE(PG8_SA(0, 0), a2, voffA);
            PG8_BAR; PG8_WAIT_L(0); PG8_MMA(1, 0, At, B0); PG8_BAR; PG8_SCHED;
            PG8_STAGE(PG8_SB(0, 1), b2 + hstep, voffB);
            PG8_WAIT_V(6); PG8_BAR; PG8_MMA(1, 1, At, B1); PG8_BAR;
            PG8_LDB(B0, 1, 0); PG8_SCHED; PG8_LDA(At, 1, 0); PG8_STAGE(PG8_SA(0, 1), a2 + hstep, voffA);
            PG8_WAIT_L(8); PG8_BAR; PG8_WAIT_L(0); PG8_MMA(0, 0, At, B0); PG8_BAR; PG8_SCHED;
            PG8_LDB(B1, 1, 1); PG8_STAGE(PG8_SB(1, 0), b3, voffB);
            PG8_BAR; PG8_WAIT_L(0); PG8_MMA(0, 1, At, B1); PG8_BAR;
            PG8_LDA(At, 1, 1); PG8_STAGE(PG8_SA(1, 0), a3, voffA);
            PG8_BAR; PG8_WAIT_L(0); PG8_MMA(1, 0, At, B0); PG8_BAR; PG8_SCHED;
            PG8_STAGE(PG8_SB(1, 1), b3 + hstep, voffB);
            PG8_WAIT_V(6); PG8_BAR; PG8_MMA(1, 1, At, B1); PG8_BAR;
            }
        }
        if constexpr (ALIGN_EPI) { if (wr == 0) PG8_BAR; }
        if constexpr (!Epi::AFTER_DRAIN) { E(acc, cur, wr, wc, fr, fq); S.done(cur); }
        if (!has_next) break;
#pragma unroll
        for (int a = 0; a < 2; ++a)
#pragma unroll
            for (int b = 0; b < 2; ++b)
#pragma unroll
                for (int m = 0; m < 4; ++m)
#pragma unroll
                    for (int n = 0; n < 2; ++n) acc[a][b][m][n] = (f32x4){0.f, 0.f, 0.f, 0.f};
        cur = nxt; cA = nA; cB = nB; ++ui;
        if constexpr (ALIGN_EPI) { if (wr == 1) PG8_BAR; }
    }
    PG8_WAIT_V(0);
    if constexpr (!ALIGN_EPI) { if (wr == 0) PG8_BAR; }
    PG8_BAR;
    if constexpr (Epi::AFTER_DRAIN) { E.fused(acc, cur, wr, wc, fr, fq, lds, wid, lane); S.done(cur); }
#undef PG8_SA
#undef PG8_SB
#undef PG8_STAGE
#undef PG8_LDA
#undef PG8_LDB
#undef PG8_MMA
#undef PG8_WAIT_V
#undef PG8_WAIT_L
#undef PG8_BAR
#undef PG8_SCHED
}
}

#define LAS __attribute__((address_space(3)))
typedef unsigned short bf16;
typedef unsigned v4u __attribute__((ext_vector_type(4)));
typedef unsigned v2u __attribute__((ext_vector_type(2)));
typedef float f32x4 __attribute__((ext_vector_type(4)));
typedef float f32x16 __attribute__((ext_vector_type(16)));
typedef float f32x2v __attribute__((ext_vector_type(2)));
typedef short bf16x8 __attribute__((ext_vector_type(8)));
#define MFMA32(a, b, c) __builtin_amdgcn_mfma_f32_32x32x16_bf16((a), (b), (c), 0, 0, 0)
#define LDS_WAIT() asm volatile("s_waitcnt lgkmcnt(0)" ::: "memory")

constexpr size_t MiB = 1u << 20;
constexpr size_t WS_WT_SSM = 0, WS_WT_CIN = 8 * MiB, WS_WT_COUT = 20 * MiB, WS_WT_FIN = 24 * MiB, WS_WT_FOUT = 68 * MiB;
constexpr size_t WS_MODS = 90 * MiB, WS_BIAS_F1 = 91 * MiB, WS_BIAS_C1 = 92 * MiB, WS_BOP = 93 * MiB, WS_COP = 94 * MiB, WS_AV = 95 * MiB, WS_AP = 95 * MiB + 65536, WS_BAR = 95 * MiB + 131072;
constexpr size_t WS_SLOTS = 96 * MiB, WS_XS = 100 * MiB, WS_R = 164 * MiB, WS_XB = 340 * MiB, WS_POP = 404 * MiB, WS_TOP = 406 * MiB, WS_QOP = 407 * MiB, WS_END = 409 * MiB;
constexpr size_t WS_NEED = WS_END;
constexpr int NWAVES = 8;
constexpr int STAGE_LDS = 131072, MISC_LDS = STAGE_LDS + 16384, LDS_BYTES = MISC_LDS + 64;

typedef float f32x2_t __attribute__((ext_vector_type(2)));
typedef __bf16 bf16x2_t __attribute__((ext_vector_type(2)));
__device__ __forceinline__ unsigned pk2(float lo, float hi) { const f32x2_t v = {lo, hi}; const bf16x2_t b = __builtin_convertvector(v, bf16x2_t); return __builtin_bit_cast(unsigned, b); }
#define WAVE_LDS_SYNC() do { __builtin_amdgcn_fence(__ATOMIC_RELEASE, "wavefront"); __builtin_amdgcn_wave_barrier(); __builtin_amdgcn_fence(__ATOMIC_ACQUIRE, "wavefront"); } while (0)
__device__ __forceinline__ float bf_lo(unsigned u) { return __builtin_bit_cast(float, u << 16); }
__device__ __forceinline__ float bf_hi(unsigned u) { return __builtin_bit_cast(float, u & 0xffff0000u); }
__device__ __forceinline__ float gelu_fast(float y) {
    const float t = y * y, u = y * __builtin_fmaf(t, -0.10294324f, -2.3022082f);
    return y * __builtin_amdgcn_rcpf(1.f + __builtin_amdgcn_exp2f(u));
}
__device__ __forceinline__ float wave_sum(float v) {
#pragma unroll
    for (int o = 1; o < 64; o <<= 1) v += __shfl_xor(v, o);
    return v;
}

#define XB_TMO      128
#define XB_XCNT(j)  (256  + 64 * (j))
#define XB_XSUB(j)  (1280 + 64 * (j))
#define XB_XGEN(j)  (2304 + 64 * (j))
#define XB_TOP      3328
#define XB_TOPGEN   3392
#define XCD_BAR_WORDS 3456
#define XB_SPIN_CAP (1u << 18)

__device__ __forceinline__ unsigned xb_ld(unsigned* p)              { return __hip_atomic_load(p, __ATOMIC_RELAXED, __HIP_MEMORY_SCOPE_AGENT); }
__device__ __forceinline__ unsigned xb_add(unsigned* p, unsigned v) { return __hip_atomic_fetch_add(p, v, __ATOMIC_RELAXED, __HIP_MEMORY_SCOPE_AGENT); }
__device__ __forceinline__ unsigned xb_xcc_id() { return (unsigned)__builtin_amdgcn_s_getreg((3 << 11) | 20) & 0xFu; }
#define XB_SPIN(cond, bar) do { unsigned _sp = 0; while (cond) { __builtin_amdgcn_s_sleep(1); \
    if ((++_sp & 255u) == 0u) { if (xb_ld(&(bar)[XB_TMO])) break; if (_sp > XB_SPIN_CAP) { atomicAdd(&(bar)[XB_TMO], 1u); break; } } } } while (0)

struct XcdBarrier {
    unsigned* bar; unsigned x;
    volatile LAS unsigned* st;
};

__device__ __forceinline__ XcdBarrier xcd_barrier_post(unsigned* bar, volatile LAS unsigned* st) {
    XcdBarrier b; b.bar = bar; b.x = xb_xcc_id(); b.st = st;
    if (threadIdx.x == 0) (void)xb_add(&bar[XB_XCNT(b.x)], 1u);
    return b;
}
__device__ __forceinline__ void xcd_barrier_complete(unsigned* bar, unsigned x, unsigned& nloc, unsigned& nx) {
    const unsigned G = gridDim.x * gridDim.y * gridDim.z;
    unsigned sum, cnt, mine, sp = 0u;
    for (;;) {
        sum = 0u; cnt = 0u; mine = 0u;
#pragma unroll
        for (unsigned j = 0; j < 16; ++j) { const unsigned c = xb_ld(&bar[XB_XCNT(j)]); sum += c; cnt += (c > 0u) ? 1u : 0u; mine = (j == x) ? c : mine; }
        if (sum == G) break;
        __builtin_amdgcn_s_sleep(1);
        if ((++sp & 255u) == 0u) { if (xb_ld(&bar[XB_TMO])) break; if (sp > XB_SPIN_CAP) { atomicAdd(&bar[XB_TMO], 1u); break; } }
    }
    nloc = mine > 0u ? mine : 1u; nx = cnt > 0u ? cnt : 1u;
}

__device__ __forceinline__ void xcd_barrier(const XcdBarrier& b) {
    asm volatile("s_waitcnt vmcnt(0)" ::: "memory");
    __syncthreads();
    if (threadIdx.x == 0) {
        unsigned* bar = b.bar; unsigned bx_ = b.x; asm volatile("" : "+s"(bx_));
        __builtin_amdgcn_s_waitcnt(0);
        unsigned nloc = b.st[0], nx = b.st[1];
        if (nloc == 0u) { xcd_barrier_complete(bar, bx_, nloc, nx); b.st[0] = nloc; b.st[1] = nx; }
        const unsigned old = xb_add(&bar[XB_XSUB(bx_)], 1u);
        const unsigned gen = old / nloc;
        if (old + 1u == (gen + 1u) * nloc) {
            __builtin_amdgcn_fence(__ATOMIC_RELEASE, "agent");
            asm volatile("s_waitcnt vmcnt(0)" ::: "memory");
            const unsigned og = xb_add(&bar[XB_TOP], 1u);
            const unsigned tg = og / nx;
            if (og + 1u == (tg + 1u) * nx) xb_add(&bar[XB_TOPGEN], 1u);
            else XB_SPIN(xb_ld(&bar[XB_TOPGEN]) == tg, bar);
            __builtin_amdgcn_fence(__ATOMIC_ACQUIRE, "agent");
            xb_add(&bar[XB_XGEN(bx_)], 1u);
            asm volatile("s_waitcnt vmcnt(0)" ::: "memory");
        } else {
            XB_SPIN(xb_ld(&bar[XB_XGEN(bx_)]) == gen, bar);
            __builtin_amdgcn_fence(__ATOMIC_ACQUIRE, "agent");
            asm volatile("s_waitcnt vmcnt(0)" ::: "memory");
        }
    }
    __syncthreads();
}

__device__ __forceinline__ void transpose_item(const float* __restrict__ W, int K, int N, bf16* WT, int mode, LAS float* scr, int item, int lane) {
    const int nblk = N / 32, kb = item / nblk, nb = item % nblk, k0 = 64 * kb, n0 = 32 * nb;
    int d0 = n0;
    if (mode == 1) { const int hN = N >> 1; if (n0 < hN) d0 = 256 * (n0 >> 7) + (n0 & 127); else { const int mm = n0 - hN; d0 = 256 * (mm >> 7) + 128 + (mm & 127); } }
    else if (mode == 2) { if (n0 < 1024) d0 = 2048 + n0; else if (n0 < 2048) { const int mm = n0 - 1024; d0 = 256 * (mm >> 7) + (mm & 127); } else { const int mm = n0 - 2048; d0 = 256 * (mm >> 7) + 128 + (mm & 127); } }
    float tv[32];
#pragma unroll
    for (int i = 0; i < 32; ++i) tv[i] = __builtin_nontemporal_load(W + (size_t)(k0 + 2 * i + (lane >> 5)) * N + n0 + (lane & 31));
#pragma unroll
    for (int i = 0; i < 32; ++i) scr[(2 * i + (lane >> 5)) * 33 + (lane & 31)] = tv[i];
    LDS_WAIT();
    const int c = lane & 7;
#pragma unroll
    for (int j = 0; j < 4; ++j) { const int n = (lane >> 3) + 8 * j; const LAS float* s = scr + (8 * c) * 33 + n;
        v4u o; o.x = pk2(s[0 * 33], s[1 * 33]); o.y = pk2(s[2 * 33], s[3 * 33]); o.z = pk2(s[4 * 33], s[5 * 33]); o.w = pk2(s[6 * 33], s[7 * 33]);
        *(v4u*)(WT + (size_t)(d0 + n) * K + k0 + 8 * c) = o; }
    LDS_WAIT();
}

struct Args { const float* in[21]; float* out; unsigned char* ws; };

struct Ctx {
    LAS unsigned char* lds; int tid, lane, wave, G, vcu, gw, NGW;
    const float *x, *c, *norm1_g, *norm2_g, *w_ada, *b_ada, *a_re, *a_im, *log_step, *b_re, *b_im, *c_re, *c_im, *ssm_d, *ssm_w_out, *conv_w_in, *conv_w, *conv_w_out, *w_ffn_in, *w_ffn_out, *final_g;
    float* out; unsigned char* ws;
};

__device__ __forceinline__ void p0a(Ctx& F) {
    int ptid_ = threadIdx.x; asm volatile("" : "+v"(ptid_)); const int plane_ = ptid_ & 63;
    float* mods = (float*)(F.ws + WS_MODS);
    LAS float* cT = (LAS float*)F.lds;
    LAS float* red = (LAS float*)(F.lds + 32768);
    for (int idx = ptid_; idx < 8192; idx += 512) { const int b = idx >> 10, k = idx & 1023; const float cv = F.c[idx]; cT[k * 8 + b] = cv * sigm(cv); }
    __syncthreads();
    for (int it = blockIdx.x; it < 256; it += F.G) {
        const int layer = it >> 6, n0 = (it & 63) * 96;
        float a0[8], a1[8];
#pragma unroll
        for (int b = 0; b < 8; ++b) { a0[b] = 0.f; a1[b] = 0.f; }
        if (plane_ < 48) {
            const float* wp = F.w_ada + ((size_t)layer * 1024 + F.wave * 128) * 6144 + n0 + 2 * plane_;
#pragma unroll 16
            for (int k = 0; k < 128; ++k) {
                float2 wv; wv.x = __builtin_nontemporal_load(wp + (size_t)k * 6144); wv.y = __builtin_nontemporal_load(wp + (size_t)k * 6144 + 1);
                const f32x4 c0 = *(const LAS f32x4*)(cT + (F.wave * 128 + k) * 8), c1 = *(const LAS f32x4*)(cT + (F.wave * 128 + k) * 8 + 4);
#pragma unroll
                for (int b = 0; b < 4; ++b) { a0[b] += c0[b] * wv.x; a1[b] += c0[b] * wv.y; a0[4 + b] += c1[b] * wv.x; a1[4 + b] += c1[b] * wv.y; }
            }
#pragma unroll
            for (int b = 0; b < 8; ++b) { red[(F.wave * 8 + b) * 96 + 2 * plane_] = a0[b]; red[(F.wave * 8 + b) * 96 + 2 * plane_ + 1] = a1[b]; }
        }
        __syncthreads();
        for (int idx = ptid_; idx < 768; idx += 512) {
            const int b = idx / 96, cc = idx % 96;
            float s = F.b_ada[layer * 6144 + n0 + cc];
#pragma unroll
            for (int w = 0; w < 8; ++w) s += red[(w * 8 + b) * 96 + cc];
            mods[((size_t)layer * 8 + b) * 6144 + n0 + cc] = s;
        }
        __syncthreads();
    }
    {
        LAS float* scr = (LAS float*)(F.lds + F.wave * 16384);
        bf16* wt_ssm = (bf16*)(F.ws + WS_WT_SSM); bf16* wt_cin = (bf16*)(F.ws + WS_WT_CIN); bf16* wt_cout = (bf16*)(F.ws + WS_WT_COUT);
        bf16* wt_fin = (bf16*)(F.ws + WS_WT_FIN); bf16* wt_fout = (bf16*)(F.ws + WS_WT_FOUT);
        constexpr int NITEMS = 2 * 1024 + 2 * 1536 + 2 * 512 + 4 * 2816 + 4 * 1408;
        for (int it = F.gw; it < NITEMS; it += F.NGW) {
            int r = it;
            if (r < 2048) { const int j = r / 1024; transpose_item(F.ssm_w_out + (size_t)j * 1024 * 2048, 1024, 2048, wt_ssm + (size_t)j * 2048 * 1024, 1, scr, r % 1024, plane_); continue; } r -= 2048;
            if (r < 3072) { const int j = r / 1536; transpose_item(F.conv_w_in + (size_t)j * 1024 * 3072, 1024, 3072, wt_cin + (size_t)j * 3072 * 1024, 2, scr, r % 1536, plane_); continue; } r -= 3072;
            if (r < 1024) { const int j = r / 512; transpose_item(F.conv_w_out + (size_t)j * 1024 * 1024, 1024, 1024, wt_cout + (size_t)j * 1024 * 1024, 0, scr, r % 512, plane_); continue; } r -= 1024;
            if (r < 11264) { const int j = r / 2816; transpose_item(F.w_ffn_in + (size_t)j * 1024 * 5632, 1024, 5632, wt_fin + (size_t)j * 5632 * 1024, 1, scr, r % 2816, plane_); continue; } r -= 11264;
            { const int j = r / 1408; transpose_item(F.w_ffn_out + (size_t)j * 2816 * 1024, 2816, 1024, wt_fout + (size_t)j * 1024 * 2816, 0, scr, r % 1408, plane_); }
        }
    }
    for (int it = F.vcu; it < 128; it += F.G) {
        const int jg = it, jl = jg >> 6, gl = jg & 63;
        LAS f32x2v* apw = (LAS f32x2v*)(F.lds + 131072);
        LAS f32x2v* qq = apw + 320;
        LAS float* kt = (LAS float*)(qq + 64);
        v4u* pop = (v4u*)(F.ws + WS_POP); v4u* top = (v4u*)(F.ws + WS_TOP); v4u* qop = (v4u*)(F.ws + WS_QOP);
        float2* av = (float2*)(F.ws + WS_AV); float2* ap = (float2*)(F.ws + WS_AP);
        __syncthreads();
        if (ptid_ < 64) {
            const int pp = ptid_;
            const SsmP P = ssm_param(F.a_re[jg * 64 + pp], F.a_im[jg * 64 + pp], F.log_step[jg]);
            double pr = 1.0, pi = 0.0;
#pragma unroll 1
            for (int n = 0; n < 5; ++n) { apw[n * 64 + pp] = (f32x2v){(float)pr, (float)pi}; const double nr = pr * P.abr - pi * P.abi, ni = pr * P.abi + pi * P.abr; if (n < 4) { pr = nr; pi = ni; } }
            qq[pp] = (f32x2v){(float)P.qr, (float)P.qi};
            av[jg * 64 + pp] = make_float2((float)pr, (float)pi);
#pragma unroll 1
            for (int sq = 0; sq < 6; ++sq) { const double nr = pr * pr - pi * pi, ni = 2.0 * pr * pi; pr = nr; pi = ni; }
            ap[jg * 64 + pp] = make_float2((float)pr, (float)pi);
        }
        __syncthreads();
        for (int idx = ptid_; idx < 1024; idx += 512) {
            const int tau = idx >> 8, h = (idx >> 4) & 15, hp = idx & 15;
            float acc = 0.f;
            for (int pp = 0; pp < 64; ++pp) {
                const f32x2v a = apw[tau * 64 + pp]; const f32x2v q = qq[pp];
                const float br = F.b_re[((size_t)jg * 64 + pp) * 16 + h], bi = F.b_im[((size_t)jg * 64 + pp) * 16 + h];
                const float bbr = q.x * br - q.y * bi, bbi = q.x * bi + q.y * br;
                const float wr = a.x * bbr - a.y * bbi, wi = a.x * bbi + a.y * bbr;
                acc += F.c_re[((size_t)jg * 16 + hp) * 64 + pp] * wr - F.c_im[((size_t)jg * 16 + hp) * 64 + pp] * wi;
            }
            kt[idx] = acc;
        }
        __syncthreads();
        for (int pr_ = ptid_; pr_ < 1024; pr_ += 512) {
            const int f = pr_ >> 6, l = pr_ & 63, sI = f >> 2, cb = f & 3, jj = l & 31, kh = l >> 5, pp = jj + 32 * (cb & 1);
            const f32x2v a = apw[(3 - sI) * 64 + pp]; const f32x2v q = qq[pp];
            float v[8];
#pragma unroll
            for (int e = 0; e < 8; ++e) {
                const float br = F.b_re[((size_t)jg * 64 + pp) * 16 + 8 * kh + e], bi = F.b_im[((size_t)jg * 64 + pp) * 16 + 8 * kh + e];
                const float bbr = q.x * br - q.y * bi, bbi = q.x * bi + q.y * br;
                v[e] = (cb < 2) ? (a.x * bbr - a.y * bbi) : (a.x * bbi + a.y * bbr);
            }
            v4u o; o.x = pk2(v[0], v[1]); o.y = pk2(v[2], v[3]); o.z = pk2(v[4], v[5]); o.w = pk2(v[6], v[7]);
            pop[((size_t)jg * 16 + f) * 64 + l] = o;
        }
        {
            const int f = ptid_ >> 6, l = ptid_ & 63, ob = f >> 2, sI = f & 3, i = l & 31, kh = l >> 5, ig = 32 * ob + i, t = ig >> 4, hp = ig & 15;
            float v[8];
#pragma unroll
            for (int e = 0; e < 8; ++e) {
                const int h = 8 * kh + e;
                float x = (sI <= t) ? kt[(t - sI) * 256 + h * 16 + hp] : 0.f;
                if (sI == t && h == hp) x += F.ssm_d[jl * 1024 + gl * 16 + hp];
                v[e] = x;
            }
            v4u o; o.x = pk2(v[0], v[1]); o.y = pk2(v[2], v[3]); o.z = pk2(v[4], v[5]); o.w = pk2(v[6], v[7]);
            top[((size_t)jg * 8 + f) * 64 + l] = o;
        }
        for (int pr_ = ptid_; pr_ < 1024; pr_ += 512) {
            const int f = pr_ >> 6, l = pr_ & 63, ob = f >> 3, ks = f & 7, i = l & 31, kh = l >> 5, ig = 32 * ob + i, t = ig >> 4, hp = ig & 15;
            float v[8];
#pragma unroll
            for (int e = 0; e < 8; ++e) {
                const int k = 16 * ks + 8 * kh + e, j2 = k >> 2, cc = k & 3, pp = j2 + 32 * (cc & 1);
                const f32x2v a = apw[(t + 1) * 64 + pp];
                const float cr = F.c_re[((size_t)jg * 16 + hp) * 64 + pp], ci = F.c_im[((size_t)jg * 16 + hp) * 64 + pp];
                v[e] = (cc < 2) ? (cr * a.x - ci * a.y) : -(cr * a.y + ci * a.x);
            }
            v4u o; o.x = pk2(v[0], v[1]); o.y = pk2(v[2], v[3]); o.z = pk2(v[4], v[5]); o.w = pk2(v[6], v[7]);
            qop[((size_t)jg * 16 + f) * 64 + l] = o;
        }
    }
}

__device__ __forceinline__ void p0b(Ctx& F) {
    int ptid_ = threadIdx.x; asm volatile("" : "+v"(ptid_)); const int plane_ = ptid_ & 63;
    const float* mods = (const float*)(F.ws + WS_MODS);
    float* slots = (float*)(F.ws + WS_SLOTS); bf16* xs = (bf16*)(F.ws + WS_XS);
    for (int row = F.gw; row < MT; row += F.NGW) {
        const int b = row >> 12;
        const f32x4* xr = (const f32x4*)(F.x + (size_t)row * Dm) + plane_;
        f32x4 v[4]; float s = 0.f;
#pragma unroll
        for (int q = 0; q < 4; ++q) { v[q] = xr[64 * q]; s += (v[q][0] * v[q][0] + v[q][1] * v[q][1]) + (v[q][2] * v[q][2] + v[q][3] * v[q][3]); }
        s = wave_sum(s);
        if (plane_ < 16) slots[(size_t)row * 32 + plane_] = (plane_ == 0) ? s : 0.f;
#pragma unroll
        for (int q = 0; q < 4; ++q) {
            const int col = 4 * (64 * q + plane_);
            const f32x4 gs = *(const f32x4*)(F.norm1_g + col) * (*(const f32x4*)(mods + (size_t)b * 6144 + 1024 + col) + 1.f);
            const f32x4 o = v[q] * gs;
            v2u w; w.x = pk2(o[0], o[1]); w.y = pk2(o[2], o[3]);
            *(v2u*)(xs + (size_t)row * Dm + col) = w;
        }
    }
    LAS float* shl = (LAS float*)F.lds;
    {
        const int per = (28672 + F.G - 1) / F.G, r_lo = F.vcu * per, r_hi = (r_lo + per < 28672) ? r_lo + per : 28672;
        for (int mi = 0; mi < 6; ++mi) {
            const int m_lo = mi < 4 ? mi * 5632 : 22528 + (mi - 4) * 3072, N = mi < 4 ? 5632 : 3072, m_hi = m_lo + N;
            const int a = r_lo > m_lo ? r_lo : m_lo, b = r_hi < m_hi ? r_hi : m_hi;
            if (a >= b) continue;
            const int layer = mi < 4 ? mi : 2 * (mi - 4) + 1, shoff = mi < 4 ? 3072 : 0;
            const bf16* Wt = mi < 4 ? (const bf16*)(F.ws + WS_WT_FIN) + (size_t)mi * 5632 * 1024 : (const bf16*)(F.ws + WS_WT_CIN) + (size_t)(mi - 4) * 3072 * 1024;
            float* outb = mi < 4 ? (float*)(F.ws + WS_BIAS_F1) + (size_t)mi * 8 * 5632 : (float*)(F.ws + WS_BIAS_C1) + (size_t)(mi - 4) * 8 * 3072;
            __syncthreads();
            for (int idx = ptid_; idx < 8192; idx += 512) shl[idx] = mods[((size_t)layer * 8 + (idx >> 10)) * 6144 + shoff + (idx & 1023)];
            __syncthreads();
            for (int n0 = a - m_lo + F.wave; n0 < b - m_lo; n0 += 4 * NWAVES) {
                v4u wv[4][2];
#pragma unroll
                for (int r = 0; r < 4; ++r) { const int n = n0 + r * NWAVES; const int nn = n < b - m_lo ? n : n0;
#pragma unroll
                    for (int i = 0; i < 2; ++i) wv[r][i] = *(const v4u*)(Wt + (size_t)nn * 1024 + 8 * plane_ + 512 * i); }
#pragma unroll
                for (int r = 0; r < 4; ++r) {
                    const int n = n0 + r * NWAVES;
                    float acc[8];
#pragma unroll
                    for (int bb = 0; bb < 8; ++bb) acc[bb] = 0.f;
#pragma unroll
                    for (int i = 0; i < 2; ++i) {
                        const int k0 = 8 * plane_ + 512 * i;
                        const v4u w = wv[r][i];
                        const float wf[8] = {bf_lo(w.x), bf_hi(w.x), bf_lo(w.y), bf_hi(w.y), bf_lo(w.z), bf_hi(w.z), bf_lo(w.w), bf_hi(w.w)};
#pragma unroll
                        for (int bb = 0; bb < 8; ++bb) {
                            const f32x4 s0 = *(const LAS f32x4*)(shl + bb * 1024 + k0), s1 = *(const LAS f32x4*)(shl + bb * 1024 + k0 + 4);
                            acc[bb] += (wf[0] * s0[0] + wf[1] * s0[1]) + (wf[2] * s0[2] + wf[3] * s0[3]) + (wf[4] * s1[0] + wf[5] * s1[1]) + (wf[6] * s1[2] + wf[7] * s1[3]);
                        }
                    }
#pragma unroll
                    for (int bb = 0; bb < 8; ++bb) acc[bb] = wave_sum(acc[bb]);
                    if (plane_ == 0 && n < b - m_lo) {
#pragma unroll
                        for (int bb = 0; bb < 8; ++bb) outb[(size_t)bb * N + n] = acc[bb];
                    }
                }
            }
        }
    }
    __syncthreads();
}

typedef float f32x2 __attribute__((ext_vector_type(2)));
template <bool DO_B = true, bool DO_ST = true> __device__ __forceinline__ void ssm_phase(Ctx& F, int j, const float* mods_l) {
    const bf16* xs = (const bf16*)(F.ws + WS_XS); const float* slots = (const float*)(F.ws + WS_SLOTS); bf16* yg = (bf16*)(F.ws + WS_R);
    LAS float* rl = (LAS float*)F.lds;
    LAS f32x4* el = (LAS f32x4*)(F.lds + 32768);
    LAS unsigned char* xt = F.lds + 49152 + F.wave * 8704;
    int lane_ = F.lane; asm volatile("" : "+v"(lane_));
    const int lane = lane_, jj = lane & 31, half = lane >> 5, w = F.wave;
    for (int chain = F.vcu; chain < 256; chain += F.G) {
        const int bp = chain >> 6, g = chain & 63, jg = j * 64 + g;
        int stid_ = threadIdx.x; asm volatile("" : "+v"(stid_));
        for (int r0 = stid_; r0 < 8192; r0 += 2048) {
            f32x4 v[4][4];
#pragma unroll
            for (int k = 0; k < 4; ++k)
#pragma unroll
                for (int q = 0; q < 4; ++q) v[k][q] = *((const f32x4*)(slots + ((size_t)bp * 8192 + r0 + 512 * k) * 32) + q);
#pragma unroll
            for (int k = 0; k < 4; ++k) {
                float s = 0.f;
#pragma unroll
                for (int q = 0; q < 4; ++q) s += (v[k][q][0] + v[k][q][1]) + (v[k][q][2] + v[k][q][3]);
                rl[r0 + 512 * k] = rsqrtf(s * (1.f / 1024.f) + 1e-6f);
            }
        }
        LAS float* shl = (LAS float*)(F.lds + 126976);
        if (stid_ < 32) shl[stid_] = mods_l[(size_t)(2 * bp + (stid_ >> 4)) * 6144 + g * 16 + (stid_ & 15)];
        __syncthreads();
        bf16x8 bop[4], dop;
#pragma unroll
        for (int cb = 0; cb < 4; ++cb) bop[cb] = __builtin_bit_cast(bf16x8, ((const v4u*)(F.ws + WS_BOP))[((size_t)jg * 4 + cb) * 64 + lane]);
        LAS v4u* copl = (LAS v4u*)(F.lds + 118784);
        if (w == 0) {
#pragma unroll
            for (int ks = 0; ks < 8; ++ks) copl[ks * 64 + lane] = ((const v4u*)(F.ws + WS_COP))[((size_t)jg * 8 + ks) * 64 + lane];
        }
        {
            const float dv = (jj < 16) ? F.ssm_d[j * 1024 + g * 16 + jj] : 0.f;
            const unsigned short db = (unsigned short)(pk2(dv, 0.f) & 0xffffu);
#pragma unroll
            for (int e = 0; e < 8; ++e) dop[e] = (short)((jj < 16 && jj == 8 * half + e) ? db : (unsigned short)0);
        }
        const float2 a0 = ((const float2*)(F.ws + WS_AV))[jg * 64 + jj], a1 = ((const float2*)(F.ws + WS_AV))[jg * 64 + jj + 32];
        const int rb = jj & 1, rh = (jj >> 2) & 1, rtau = ((jj >> 1) & 1) + 2 * (jj >> 3);
        const size_t rowbase = (size_t)(2 * bp + rb) * SEQ + 256 * (w + 8 * rh) + rtau;
        const bf16* up = xs + rowbase * Dm + g * 16 + 8 * half;
        const LAS float* rlp = rl + rb * SEQ + 256 * (w + 8 * rh) + rtau;
        const LAS f32x4* shp = (const LAS f32x4*)(shl + (rb * 2 + half) * 8);
        f32x16 zero16;
#pragma unroll
        for (int i = 0; i < 16; ++i) zero16[i] = 0.f;
        f32x2 pr0 = {0.f, 0.f}, pi0 = {0.f, 0.f}, pr1 = {0.f, 0.f}, pi1 = {0.f, 0.f};
#define SSM_UOP(raw, t0, uop) do { const float rs_ = rlp[(t0)]; v4u p_; const f32x4 s0_ = shp[0], s1_ = shp[1]; const float sh[8] = {s0_[0], s0_[1], s0_[2], s0_[3], s1_[0], s1_[1], s1_[2], s1_[3]}; \
            p_.x = pk2(bf_lo((raw).x) * rs_ + sh[0], bf_hi((raw).x) * rs_ + sh[1]); p_.y = pk2(bf_lo((raw).y) * rs_ + sh[2], bf_hi((raw).y) * rs_ + sh[3]); \
            p_.z = pk2(bf_lo((raw).z) * rs_ + sh[4], bf_hi((raw).z) * rs_ + sh[5]); p_.w = pk2(bf_lo((raw).w) * rs_ + sh[6], bf_hi((raw).w) * rs_ + sh[7]); \
            uop = __builtin_bit_cast(bf16x8, p_); } while (0)
#define SSM_STEP(tau) do { const f32x2 dr0 = {d0[2 * (tau)], d0[2 * (tau) + 1]}, di0 = {d2[2 * (tau)], d2[2 * (tau) + 1]}, dr1 = {d1[2 * (tau)], d1[2 * (tau) + 1]}, di1 = {d3[2 * (tau)], d3[2 * (tau) + 1]}; \
            const f32x2 nr0 = pr0 * a0.x - pi0 * a0.y + dr0, ni0 = pi0 * a0.x + pr0 * a0.y + di0, nr1 = pr1 * a1.x - pi1 * a1.y + dr1, ni1 = pi1 * a1.x + pr1 * a1.y + di1; \
            pr0 = nr0; pi0 = ni0; pr1 = nr1; pi1 = ni1; } while (0)
        {
            v4u r0 = *(const v4u*)(up), r1 = *(const v4u*)(up + (size_t)8 * Dm), r2 = *(const v4u*)(up + (size_t)16 * Dm), r3 = *(const v4u*)(up + (size_t)24 * Dm),
                r4 = *(const v4u*)(up + (size_t)32 * Dm), r5 = *(const v4u*)(up + (size_t)40 * Dm);
            for (int tile = 0; tile < 32; ++tile) {
                const int t0 = 8 * tile;
                const v4u cur = r0;
                r0 = r1; r1 = r2; r2 = r3; r3 = r4; r4 = r5;
                if (tile < 26) r5 = *(const v4u*)(up + (size_t)(t0 + 48) * Dm);
                bf16x8 uop; SSM_UOP(cur, t0, uop);
                const f32x16 d0 = MFMA32(uop, bop[0], zero16), d1 = MFMA32(uop, bop[1], zero16), d2 = MFMA32(uop, bop[2], zero16), d3 = MFMA32(uop, bop[3], zero16);
#pragma unroll
                for (int tau = 0; tau < 8; ++tau) SSM_STEP(tau);
            }
        }
        {
            const int mych = w + 8 * half;
            el[(mych * 32 + jj) * 2] = (f32x4){pr0.x, pr0.y, pi0.x, pi0.y};
            el[(mych * 32 + jj) * 2 + 1] = (f32x4){pr1.x, pr1.y, pi1.x, pi1.y};
            __syncthreads();
            const float2 p0 = ((const float2*)(F.ws + WS_AP))[jg * 64 + jj], p1 = ((const float2*)(F.ws + WS_AP))[jg * 64 + jj + 32];
            pr0 = (f32x2){0.f, 0.f}; pi0 = pr0; pr1 = pr0; pi1 = pr0;
            for (int c = 0; c < mych; ++c) {
                const f32x4 e0 = el[(c * 32 + jj) * 2], e1 = el[(c * 32 + jj) * 2 + 1];
                const f32x2 nr0 = pr0 * p0.x - pi0 * p0.y + (f32x2){e0[0], e0[1]}, ni0 = pi0 * p0.x + pr0 * p0.y + (f32x2){e0[2], e0[3]};
                const f32x2 nr1 = pr1 * p1.x - pi1 * p1.y + (f32x2){e1[0], e1[1]}, ni1 = pi1 * p1.x + pr1 * p1.y + (f32x2){e1[2], e1[3]};
                pr0 = nr0; pi0 = ni0; pr1 = nr1; pi1 = ni1;
            }
        }
        if (DO_B) {
            bf16* yp = yg + rowbase * Dm + g * 16 + 4 * half;
#define SSM_SCAN_WRITE() do { _Pragma("unroll") for (int tau = 0; tau < 8; ++tau) { SSM_STEP(tau); \
                    v2u w0, w1; w0.x = pk2(pr0.x, pr1.x); w0.y = pk2(pi0.x, pi1.x); w1.x = pk2(pr0.y, pr1.y); w1.y = pk2(pi0.y, pi1.y); \
                    *(LAS v2u*)(xt + (((2 * tau) & 3) + 8 * ((2 * tau) >> 2) + 4 * half) * 272 + 8 * jj) = w0; \
                    *(LAS v2u*)(xt + (((2 * tau + 1) & 3) + 8 * ((2 * tau + 1) >> 2) + 4 * half) * 272 + 8 * jj) = w1; } } while (0)
#define SSM_CPROD(y, uprev) do { y = zero16; _Pragma("unroll") for (int ks = 0; ks < 8; ++ks) { const bf16x8 xop = *(const LAS bf16x8*)(xt + jj * 272 + 32 * ks + 16 * half); y = MFMA32(__builtin_bit_cast(bf16x8, copl[ks * 64 + lane]), xop, y); } \
                    y = MFMA32(dop, uprev, y); } while (0)
#define SSM_OUT(y, tp) do { v2u o0, o1; o0.x = pk2(gelu_tanh(y[0]), gelu_tanh(y[1])); o0.y = pk2(gelu_tanh(y[2]), gelu_tanh(y[3])); \
                    o1.x = pk2(gelu_tanh(y[4]), gelu_tanh(y[5])); o1.y = pk2(gelu_tanh(y[6]), gelu_tanh(y[7])); \
                    if (DO_ST || (o0.x ^ o1.y) == 0x12345679u) { *(v2u*)(yp + (size_t)(tp) * Dm) = o0; *(v2u*)(yp + (size_t)(tp) * Dm + 8) = o1; } } while (0)
            v4u r0 = *(const v4u*)(up);
            bf16x8 uprev;
            {
                const v4u cur = r0; r0 = *(const v4u*)(up + (size_t)8 * Dm);
                bf16x8 uop; SSM_UOP(cur, 0, uop);
                const f32x16 d0 = MFMA32(uop, bop[0], zero16), d1 = MFMA32(uop, bop[1], zero16), d2 = MFMA32(uop, bop[2], zero16), d3 = MFMA32(uop, bop[3], zero16);
                SSM_SCAN_WRITE();
                uprev = uop;
            }
            for (int tile = 1; tile < 32; ++tile) {
                const int t0 = 8 * tile;
                const v4u cur = r0;
                if (tile < 31) r0 = *(const v4u*)(up + (size_t)(t0 + 8) * Dm);
                bf16x8 uop; SSM_UOP(cur, t0, uop);
                const f32x16 d0 = MFMA32(uop, bop[0], zero16), d1 = MFMA32(uop, bop[1], zero16), d2 = MFMA32(uop, bop[2], zero16), d3 = MFMA32(uop, bop[3], zero16);
                WAVE_LDS_SYNC();
                f32x16 y; SSM_CPROD(y, uprev);
                WAVE_LDS_SYNC();
                SSM_SCAN_WRITE();
                SSM_OUT(y, t0 - 8);
                uprev = uop;
            }
            {
                WAVE_LDS_SYNC();
                f32x16 y; SSM_CPROD(y, uprev);
                SSM_OUT(y, 248);
            }
#undef SSM_SCAN_WRITE
#undef SSM_CPROD
#undef SSM_OUT
        }
#undef SSM_UOP
#undef SSM_STEP
        if (!DO_B && pr0.x + pi0.x + pr1.y + pi1.y == 1.2345e30f) rl[0] = 1.f;
        __syncthreads();
    }
}

__device__ __forceinline__ void ssm_phase2(Ctx& F, int j, const float* mods_l) {
    const bf16* xs = (const bf16*)(F.ws + WS_XS); const float* slots = (const float*)(F.ws + WS_SLOTS); bf16* yg = (bf16*)(F.ws + WS_R);
    LAS float* rl = (LAS float*)F.lds;
    LAS v4u* popl = (LAS v4u*)(F.lds + 32768);
    LAS v4u* topl = (LAS v4u*)(F.lds + 49152);
    LAS v4u* qopl = (LAS v4u*)(F.lds + 57344);
    LAS unsigned char* xt = F.lds + 73728 + F.wave * 8704;
    LAS f32x4* el = (LAS f32x4*)(F.lds + 73728);
    LAS float* shl = (LAS float*)(F.lds + 73728 + 8 * 8704);
    int lane_ = threadIdx.x & 63; asm volatile("" : "+v"(lane_));
    const int lane = lane_, jj = lane & 31, half = lane >> 5, w = F.wave;
    for (int chain = F.vcu; chain < 256; chain += F.G) {
        const int bp = chain >> 6, g = chain & 63, jg = j * 64 + g;
        int stid_ = threadIdx.x; asm volatile("" : "+v"(stid_));
        for (int r0 = stid_; r0 < 8192; r0 += 2048) {
            f32x4 v[4][4];
#pragma unroll
            for (int k = 0; k < 4; ++k)
#pragma unroll
                for (int q = 0; q < 4; ++q) v[k][q] = *((const f32x4*)(slots + ((size_t)bp * 8192 + r0 + 512 * k) * 32) + q);
#pragma unroll
            for (int k = 0; k < 4; ++k) {
                float sm = 0.f;
#pragma unroll
                for (int q = 0; q < 4; ++q) sm += (v[k][q][0] + v[k][q][1]) + (v[k][q][2] + v[k][q][3]);
                rl[r0 + 512 * k] = rsqrtf(sm * (1.f / 1024.f) + 1e-6f);
            }
        }
        if (stid_ < 32) shl[stid_] = mods_l[(size_t)(2 * bp + (stid_ >> 4)) * 6144 + g * 16 + (stid_ & 15)];
        {
            v4u o[5];
#pragma unroll
            for (int k = 0; k < 5; ++k) {
                const int idx = stid_ + 512 * k;
                if (idx < 1024) o[k] = ((const v4u*)(F.ws + WS_POP))[(size_t)jg * 1024 + idx];
                else if (idx < 1536) o[k] = ((const v4u*)(F.ws + WS_TOP))[(size_t)jg * 512 + idx - 1024];
                else o[k] = ((const v4u*)(F.ws + WS_QOP))[(size_t)jg * 1024 + idx - 1536];
            }
#pragma unroll
            for (int k = 0; k < 5; ++k) popl[stid_ + 512 * k] = o[k];
        }
        __syncthreads();
        const float2 a0 = ((const float2*)(F.ws + WS_AV))[jg * 64 + jj], a1 = ((const float2*)(F.ws + WS_AV))[jg * 64 + jj + 32];
        const f32x2 ax0 = {a0.x, a0.x}, ay0 = {a0.y, a0.y}, ax1 = {a1.x, a1.x}, ay1 = {a1.y, a1.y};
        const int rb = jj & 1, rh = (jj >> 2) & 1, rk = ((jj >> 1) & 1) + 2 * (jj >> 3);
        const size_t rowbase = (size_t)(2 * bp + rb) * SEQ + 256 * (w + 8 * rh) + 4 * rk;
        const bf16* up = xs + rowbase * Dm + g * 16 + 8 * half;
        const LAS float* rlp = rl + rb * SEQ + 256 * (w + 8 * rh) + 4 * rk;
        const LAS f32x4* shp = (const LAS f32x4*)(shl + (rb * 2 + half) * 8);
        f32x16 zero16;
#pragma unroll
        for (int i = 0; i < 16; ++i) zero16[i] = 0.f;
        f32x2 pr0 = {0.f, 0.f}, pi0 = {0.f, 0.f}, pr1 = {0.f, 0.f}, pi1 = {0.f, 0.f};
#define S2_UOP(raw, toff, uop) do { const float rs_ = rlp[(toff)]; const f32x4 s0_ = shp[0], s1_ = shp[1]; v4u p_; \
            p_.x = pk2(bf_lo((raw).x) * rs_ + s0_[0], bf_hi((raw).x) * rs_ + s0_[1]); p_.y = pk2(bf_lo((raw).y) * rs_ + s0_[2], bf_hi((raw).y) * rs_ + s0_[3]); \
            p_.z = pk2(bf_lo((raw).z) * rs_ + s1_[0], bf_hi((raw).z) * rs_ + s1_[1]); p_.w = pk2(bf_lo((raw).w) * rs_ + s1_[2], bf_hi((raw).w) * rs_ + s1_[3]); \
            uop = __builtin_bit_cast(bf16x8, p_); } while (0)
#define S2_ESTEP(k) do { const f32x2 dr0 = {d0[2 * (k)], d0[2 * (k) + 1]}, di0 = {d2[2 * (k)], d2[2 * (k) + 1]}, dr1 = {d1[2 * (k)], d1[2 * (k) + 1]}, di1 = {d3[2 * (k)], d3[2 * (k) + 1]}; \
            const f32x2 nr0 = __builtin_elementwise_fma(-pi0, ay0, __builtin_elementwise_fma(pr0, ax0, dr0)), ni0 = __builtin_elementwise_fma(pr0, ay0, __builtin_elementwise_fma(pi0, ax0, di0)); \
            const f32x2 nr1 = __builtin_elementwise_fma(-pi1, ay1, __builtin_elementwise_fma(pr1, ax1, dr1)), ni1 = __builtin_elementwise_fma(pr1, ay1, __builtin_elementwise_fma(pi1, ax1, di1)); \
            pr0 = nr0; pi0 = ni0; pr1 = nr1; pi1 = ni1; } while (0)
#define S2_EPROD() f32x16 d0 = zero16, d1 = zero16, d2 = zero16, d3 = zero16; _Pragma("unroll") for (int sI = 0; sI < 4; ++sI) { \
            d0 = MFMA32(u[sI], __builtin_bit_cast(bf16x8, popl[(sI * 4 + 0) * 64 + lane]), d0); d1 = MFMA32(u[sI], __builtin_bit_cast(bf16x8, popl[(sI * 4 + 1) * 64 + lane]), d1); \
            d2 = MFMA32(u[sI], __builtin_bit_cast(bf16x8, popl[(sI * 4 + 2) * 64 + lane]), d2); d3 = MFMA32(u[sI], __builtin_bit_cast(bf16x8, popl[(sI * 4 + 3) * 64 + lane]), d3); }
        {
            v4u raw[4];
#pragma unroll
            for (int sI = 0; sI < 4; ++sI) raw[sI] = *(const v4u*)(up + (size_t)sI * Dm);
            for (int rbk = 0; rbk < 8; ++rbk) {
                bf16x8 u[4];
#pragma unroll
                for (int sI = 0; sI < 4; ++sI) { S2_UOP(raw[sI], 32 * rbk + sI, u[sI]); if (rbk < 7) raw[sI] = *(const v4u*)(up + (size_t)(32 * (rbk + 1) + sI) * Dm); }
                S2_EPROD();
#pragma unroll
                for (int k = 0; k < 8; ++k) S2_ESTEP(k);
            }
        }
        {
            const int mych = w + 8 * half;
            __syncthreads();
            el[(mych * 32 + jj) * 2] = (f32x4){pr0.x, pr0.y, pi0.x, pi0.y};
            el[(mych * 32 + jj) * 2 + 1] = (f32x4){pr1.x, pr1.y, pi1.x, pi1.y};
            __syncthreads();
            const float2 p0 = ((const float2*)(F.ws + WS_AP))[jg * 64 + jj], p1 = ((const float2*)(F.ws + WS_AP))[jg * 64 + jj + 32];
            pr0 = (f32x2){0.f, 0.f}; pi0 = pr0; pr1 = pr0; pi1 = pr0;
            for (int c = 0; c < mych; ++c) {
                const f32x4 e0 = el[(c * 32 + jj) * 2], e1 = el[(c * 32 + jj) * 2 + 1];
                const f32x2 nr0 = pr0 * p0.x - pi0 * p0.y + (f32x2){e0[0], e0[1]}, ni0 = pi0 * p0.x + pr0 * p0.y + (f32x2){e0[2], e0[3]};
                const f32x2 nr1 = pr1 * p1.x - pi1 * p1.y + (f32x2){e1[0], e1[1]}, ni1 = pi1 * p1.x + pr1 * p1.y + (f32x2){e1[2], e1[3]};
                pr0 = nr0; pi0 = ni0; pr1 = nr1; pi1 = ni1;
            }
            __syncthreads();
        }
        {
            bf16* yp = yg + rowbase * Dm + g * 16 + 4 * half;
            v4u raw[4];
#pragma unroll
            for (int sI = 0; sI < 4; ++sI) raw[sI] = *(const v4u*)(up + (size_t)sI * Dm);
            for (int rbk = 0; rbk < 8; ++rbk) {
                bf16x8 u[4];
#pragma unroll
                for (int sI = 0; sI < 4; ++sI) { S2_UOP(raw[sI], 32 * rbk + sI, u[sI]); if (rbk < 7) raw[sI] = *(const v4u*)(up + (size_t)(32 * (rbk + 1) + sI) * Dm); }
                S2_EPROD();
#pragma unroll
                for (int k = 0; k < 8; ++k) {
                    v2u w0, w1; w0.x = pk2(pr0.x, pr1.x); w0.y = pk2(pi0.x, pi1.x); w1.x = pk2(pr0.y, pr1.y); w1.y = pk2(pi0.y, pi1.y);
                    *(LAS v2u*)(xt + (((2 * k) & 3) + 8 * ((2 * k) >> 2) + 4 * half) * 272 + 8 * jj) = w0;
                    *(LAS v2u*)(xt + (((2 * k + 1) & 3) + 8 * ((2 * k + 1) >> 2) + 4 * half) * 272 + 8 * jj) = w1;
                    S2_ESTEP(k);
                }
                WAVE_LDS_SYNC();
#pragma unroll
                for (int ob = 0; ob < 2; ++ob) {
                    f32x16 y = zero16;
#pragma unroll
                    for (int sI = 0; sI < 4; ++sI) y = MFMA32(__builtin_bit_cast(bf16x8, topl[(ob * 4 + sI) * 64 + lane]), u[sI], y);
#pragma unroll
                    for (int ks = 0; ks < 8; ++ks) {
                        const bf16x8 xop = *(const LAS bf16x8*)(xt + jj * 272 + 32 * ks + 16 * half);
                        y = MFMA32(__builtin_bit_cast(bf16x8, qopl[(ob * 8 + ks) * 64 + lane]), xop, y);
                    }
#pragma unroll
                    for (int tl = 0; tl < 2; ++tl) {
                        v2u o0, o1;
                        o0.x = pk2(gelu_fast(y[8 * tl + 0]), gelu_fast(y[8 * tl + 1])); o0.y = pk2(gelu_fast(y[8 * tl + 2]), gelu_fast(y[8 * tl + 3]));
                        o1.x = pk2(gelu_fast(y[8 * tl + 4]), gelu_fast(y[8 * tl + 5])); o1.y = pk2(gelu_fast(y[8 * tl + 6]), gelu_fast(y[8 * tl + 7]));
                        bf16* q = yp + (size_t)(32 * rbk + 2 * ob + tl) * Dm;
                        *(v2u*)(q) = o0; *(v2u*)(q + 8) = o1;
                    }
                }
                WAVE_LDS_SYNC();
            }
        }
#undef S2_UOP
#undef S2_ESTEP
#undef S2_EPROD
        __syncthreads();
    }
}

__device__ __forceinline__ void conv_phase(Ctx& F, int j) {
    bf16* bg = (bf16*)(F.ws + WS_R); const bf16* cv = (const bf16*)(F.ws + WS_R + 64 * MiB);
    int tid_ = F.tid; asm volatile("" : "+v"(tid_));
    const int co = tid_ & 127, rb = tid_ >> 7;
    float w0[8], w1[8], w2[8];
#pragma unroll
    for (int e = 0; e < 8; ++e) { w0[e] = F.conv_w[(size_t)j * 3072 + 8 * co + e]; w1[e] = F.conv_w[(size_t)j * 3072 + 1024 + 8 * co + e]; w2[e] = F.conv_w[(size_t)j * 3072 + 2048 + 8 * co + e]; }
    for (int item = blockIdx.x; item < MT / 64; item += F.G) {
        const int r0 = item * 64 + rb * 16;
        float m2[8], m1[8];
        if ((r0 & (SEQ - 1)) != 0) {
            const v4u a = *(const v4u*)(cv + (size_t)(r0 - 2) * Dm + 8 * co), b = *(const v4u*)(cv + (size_t)(r0 - 1) * Dm + 8 * co);
            m2[0] = bf_lo(a.x); m2[1] = bf_hi(a.x); m2[2] = bf_lo(a.y); m2[3] = bf_hi(a.y); m2[4] = bf_lo(a.z); m2[5] = bf_hi(a.z); m2[6] = bf_lo(a.w); m2[7] = bf_hi(a.w);
            m1[0] = bf_lo(b.x); m1[1] = bf_hi(b.x); m1[2] = bf_lo(b.y); m1[3] = bf_hi(b.y); m1[4] = bf_lo(b.z); m1[5] = bf_hi(b.z); m1[6] = bf_lo(b.w); m1[7] = bf_hi(b.w);
        } else {
#pragma unroll
            for (int e = 0; e < 8; ++e) { m2[e] = 0.f; m1[e] = 0.f; }
        }
#pragma unroll 4
        for (int r = 0; r < 16; ++r) {
            const size_t o = (size_t)(r0 + r) * Dm + 8 * co;
            const v4u cc = *(const v4u*)(cv + o), bb = *(const v4u*)(bg + o);
            const float c0[8] = {bf_lo(cc.x), bf_hi(cc.x), bf_lo(cc.y), bf_hi(cc.y), bf_lo(cc.z), bf_hi(cc.z), bf_lo(cc.w), bf_hi(cc.w)};
            const float bv[8] = {bf_lo(bb.x), bf_hi(bb.x), bf_lo(bb.y), bf_hi(bb.y), bf_lo(bb.z), bf_hi(bb.z), bf_lo(bb.w), bf_hi(bb.w)};
            float p[8];
#pragma unroll
            for (int e = 0; e < 8; ++e) { p[e] = bv[e] * (w0[e] * m2[e] + w1[e] * m1[e] + w2[e] * c0[e]); m2[e] = m1[e]; m1[e] = c0[e]; }
            v4u w; w.x = pk2(p[0], p[1]); w.y = pk2(p[2], p[3]); w.z = pk2(p[4], p[5]); w.w = pk2(p[6], p[7]);
            *(v4u*)(bg + o) = w;
        }
    }
}

__device__ __forceinline__ void final_phase(Ctx& F) {
    const float* slots = (const float*)(F.ws + WS_SLOTS);
    int ft_ = threadIdx.x; asm volatile("" : "+v"(ft_)); const int fl_ = ft_ & 63, fgw_ = F.vcu * NWAVES + __builtin_amdgcn_readfirstlane(ft_ >> 6);
    f32x4 g[4];
#pragma unroll
    for (int q = 0; q < 4; ++q) g[q] = *((const f32x4*)F.final_g + 64 * q + fl_);
    for (int row = fgw_; row < MT; row += 2 * F.NGW) {
        const int row2 = row + F.NGW; const bool has2 = row2 < MT;
        f32x4* xa = (f32x4*)(F.out + (size_t)row * Dm) + fl_;
        f32x4* xb2 = (f32x4*)(F.out + (size_t)(has2 ? row2 : row) * Dm) + fl_;
        f32x4 va[4], vb[4];
#pragma unroll
        for (int q = 0; q < 4; ++q) { va[q] = xa[64 * q]; vb[q] = xb2[64 * q]; }
        float sa = 0.f, sb = 0.f;
        if (fl_ < 16) { sa = slots[(size_t)row * 32 + fl_]; sb = slots[(size_t)(has2 ? row2 : row) * 32 + fl_]; }
        sa = wave_sum(sa); sb = wave_sum(sb);
        const float ra = rsqrtf(sa * (1.f / 1024.f) + 1e-6f), rb = rsqrtf(sb * (1.f / 1024.f) + 1e-6f);
#pragma unroll
        for (int q = 0; q < 4; ++q) xa[64 * q] = va[q] * ra * g[q];
        if (has2) {
#pragma unroll
            for (int q = 0; q < 4; ++q) xb2[64 * q] = vb[q] * rb * g[q];
        }
    }
}

#ifndef PH_LO
#define PH_LO 0
#endif
#ifndef PH_HI
#define PH_HI 99
#endif
__global__ void __launch_bounds__(NWAVES * 64, 2) fwd_megakernel(Args args) {
    extern __shared__ __attribute__((aligned(16))) unsigned char lds_raw[];
    cg::grid_group grid = cg::this_grid();
#define GRID_SYNC() xcd_barrier(bar)
    Ctx F;
    F.lds = (LAS unsigned char*)lds_raw;
    F.tid = threadIdx.x; F.lane = F.tid & 63; F.wave = __builtin_amdgcn_readfirstlane(F.tid >> 6);
    F.G = gridDim.x; { const int bx = blockIdx.x; F.vcu = (F.G % 8 == 0) ? (bx % 8) * (F.G / 8) + bx / 8 : bx; }
    F.gw = F.vcu * NWAVES + F.wave; F.NGW = F.G * NWAVES;
    F.x = args.in[0]; F.c = args.in[1]; F.norm1_g = args.in[2]; F.norm2_g = args.in[3]; F.w_ada = args.in[4]; F.b_ada = args.in[5];
    F.a_re = args.in[6]; F.a_im = args.in[7]; F.log_step = args.in[8]; F.b_re = args.in[9]; F.b_im = args.in[10]; F.c_re = args.in[11]; F.c_im = args.in[12];
    F.ssm_d = args.in[13]; F.ssm_w_out = args.in[14]; F.conv_w_in = args.in[15]; F.conv_w = args.in[16]; F.conv_w_out = args.in[17];
    F.w_ffn_in = args.in[18]; F.w_ffn_out = args.in[19]; F.final_g = args.in[20]; F.out = args.out; F.ws = args.ws;
    unsigned char* ws = args.ws;
    const float* mods = (const float*)(ws + WS_MODS);
    float* slots = (float*)(ws + WS_SLOTS); bf16* xs = (bf16*)(ws + WS_XS); bf16* xb = (bf16*)(ws + WS_XB);
    pg8::bf16_t* R = (pg8::bf16_t*)(ws + WS_R);
    PG8_LAS float* rl = (PG8_LAS float*)(F.lds + STAGE_LDS);
    PG8_LAS unsigned char* glds = (PG8_LAS unsigned char*)F.lds;

    {
        volatile LAS unsigned* misc = (volatile LAS unsigned*)(F.lds + MISC_LDS);
        if (F.tid < 4) misc[F.tid] = 0u;
        __syncthreads();
    }
    const XcdBarrier bar = xcd_barrier_post((unsigned*)(ws + WS_BAR), (volatile LAS unsigned*)(F.lds + MISC_LDS));
    if (args.out == nullptr) grid.sync();
    p0a(F);
    GRID_SYNC();
    p0b(F);
    GRID_SYNC();
#ifdef PROBE_P0
#if PROBE_P0 != 3
    p0a(F);
    GRID_SYNC();
#endif
#if PROBE_P0 != 2
    p0b(F);
    GRID_SYNC();
#endif
#endif
    for (int i = 0; i < 4; ++i) {
        const int j = i >> 1;
        const float* ml = mods + (size_t)i * 8 * 6144;
        if ((i & 1) == 0) {
            ssm_phase2(F, j, ml);
#ifdef PROBE_SSM
            GRID_SYNC(); ssm_phase2(F, j, ml);
#endif
            GRID_SYNC();
            {
                pg8::Gemm g{R, (const pg8::bf16_t*)(ws + WS_WT_SSM) + (size_t)j * 2048 * 1024, MT, 2048, 1024};
                pg8::StaticOrder S; S.init(MT, 2048, F.G, (int)blockIdx.x);
                if (i == 0) {
                    pg8::EpiGluRes<true> E{F.x, xb, xb, xs, ml + 2048, F.norm2_g + i * Dm, ml + 4096, slots};
                    pg8::gemm_phase<pg8::EpiGluRes<true>, pg8::StaticOrder, true, true>(glds, g, S, E);
                } else {
                    pg8::EpiGluRes<false> E{F.x, xb, xb, xs, ml + 2048, F.norm2_g + i * Dm, ml + 4096, slots};
                    pg8::gemm_phase<pg8::EpiGluRes<false>, pg8::StaticOrder, true, true>(glds, g, S, E);
                }
            }
            GRID_SYNC();
        } else {
            {
                pg8::Gemm g{xs, (const pg8::bf16_t*)(ws + WS_WT_CIN) + (size_t)j * 3072 * 1024, MT, 2048, 1024};
                pg8::StaticOrder S; S.init(MT, 2048, F.G, (int)blockIdx.x);
                pg8::phase_rstd<16>(rl, slots, S);
                pg8::EpiCV E{R + (size_t)MT * Dm, (const float*)(ws + WS_BIAS_C1) + (size_t)j * 8 * 3072, rl};
                pg8::gemm_phase<pg8::EpiCV, pg8::StaticOrder, true, true>(glds, g, S, E);
            }
            GRID_SYNC();
            {
                pg8::Gemm g{xs, (const pg8::bf16_t*)(ws + WS_WT_CIN) + (size_t)j * 3072 * 1024 + (size_t)2048 * 1024, MT, 1024, 1024};
                pg8::StaticOrder S; S.init(MT, 1024, F.G, (int)blockIdx.x);
                pg8::phase_rstd<16>(rl, slots, S);
                pg8::EpiBGP E{R + (size_t)MT * Dm, R, (const float*)(ws + WS_BIAS_C1) + (size_t)j * 8 * 3072, F.conv_w + (size_t)j * 3072, rl};
                pg8::gemm_phase<pg8::EpiBGP, pg8::StaticOrder, true, true>(glds, g, S, E);
            }
            GRID_SYNC();
            {
                pg8::Gemm g{R, (const pg8::bf16_t*)(ws + WS_WT_COUT) + (size_t)j * 1024 * 1024, MT, 1024, 1024};
                pg8::StaticOrder S; S.init(MT, 1024, F.G, (int)blockIdx.x);
                pg8::EpiRes<false> E{xb, xb, F.out, xs, ml + 2048, F.norm2_g + i * Dm, ml + 4096, slots};
                pg8::gemm_phase<pg8::EpiRes<false>, pg8::StaticOrder, true, true>(glds, g, S, E);
            }
            GRID_SYNC();
        }
        {
            pg8::Gemm g{xs, (const pg8::bf16_t*)(ws + WS_WT_FIN) + (size_t)i * 5632 * 1024, MT, 5632, 1024};
            pg8::StaticOrder S; S.init(MT, 5632, F.G, (int)blockIdx.x);
            if (i & 1) {
                pg8::phase_rstd<16>(rl, slots, S);
                pg8::EpiF1<16> E{R, (const float*)(ws + WS_BIAS_F1) + (size_t)i * 8 * 5632, slots, rl};
                pg8::gemm_phase<pg8::EpiF1<16>, pg8::StaticOrder, true, true>(glds, g, S, E);
            } else {
                pg8::phase_rstd<32>(rl, slots, S);
                pg8::EpiF1<32> E{R, (const float*)(ws + WS_BIAS_F1) + (size_t)i * 8 * 5632, slots, rl};
                pg8::gemm_phase<pg8::EpiF1<32>, pg8::StaticOrder, true, true>(glds, g, S, E);
            }
        }
        GRID_SYNC();
#ifdef PROBE_F1DUP
        {
            pg8::Gemm g{xs, (const pg8::bf16_t*)(ws + WS_WT_FIN) + (size_t)i * 5632 * 1024, MT, 5632, 1024};
            pg8::StaticOrder S; S.init(MT, 5632, F.G, (int)blockIdx.x);
            if (i & 1) pg8::phase_rstd<16>(rl, slots, S); else pg8::phase_rstd<32>(rl, slots, S);
            pg8::EpiF1<32> E{R, (const float*)(ws + WS_BIAS_F1) + (size_t)i * 8 * 5632, slots, rl};
            pg8::gemm_phase<pg8::EpiF1<32>, pg8::StaticOrder, true, true>(glds, g, S, E);
        }
        GRID_SYNC();
#endif
#ifdef PROBE_F1NULL
        {
            pg8::Gemm g{xs, (const pg8::bf16_t*)(ws + WS_WT_FIN) + (size_t)i * 5632 * 1024, MT, 5632, 1024};
            pg8::StaticOrder S; S.init(MT, 5632, F.G, (int)blockIdx.x);
            pg8::EpiNull E{slots};
            pg8::gemm_phase<pg8::EpiNull, pg8::StaticOrder, true, true>(glds, g, S, E);
        }
        GRID_SYNC();
#endif
#ifdef PROBE_F2NULL
        {
            pg8::Gemm g{R, (const pg8::bf16_t*)(ws + WS_WT_FOUT) + (size_t)i * 1024 * 2816, MT, 1024, 2816};
            pg8::StaticOrder S; S.init(MT, 1024, F.G, (int)blockIdx.x);
            pg8::EpiNull E{slots};
            pg8::gemm_phase<pg8::EpiNull, pg8::StaticOrder, true, true>(glds, g, S, E);
        }
        GRID_SYNC();
#endif
        {
            pg8::Gemm g{R, (const pg8::bf16_t*)(ws + WS_WT_FOUT) + (size_t)i * 1024 * 2816, MT, 1024, 2816};
            pg8::StaticOrder S; S.init(MT, 1024, F.G, (int)blockIdx.x);
            const float* mn = mods + (size_t)(i + 1) * 8 * 6144;
            if (i < 3) {
                pg8::EpiRes<false> E{xb, xb, F.out, xs, ml + 5120, F.norm1_g + (i + 1) * Dm, mn + 1024, slots};
                pg8::gemm_phase<pg8::EpiRes<false>, pg8::StaticOrder, true, true>(glds, g, S, E);
            } else {
                pg8::EpiRes<true> E{xb, xb, F.out, xs, ml + 5120, F.norm1_g, ml, slots};
                pg8::gemm_phase<pg8::EpiRes<true>, pg8::StaticOrder, true, true>(glds, g, S, E);
            }
        }
        GRID_SYNC();
    }
    final_phase(F);
}

extern "C" void kernel_launch(void* const* d_in, const int* in_sizes, int n_in, void* d_out, int out_size, void* d_ws, size_t ws_size, hipStream_t stream) {
    static int grid = 0;
    if (grid == 0) {
        if (n_in != 21 || ws_size < WS_NEED) { fprintf(stderr, "kernel_launch: unexpected inputs (n_in %d, ws %zu)\n", n_in, ws_size); grid = -1; return; }
        int dev = 0, cus = 0, per_cu = 0;
        hipGetDevice(&dev);
        hipDeviceGetAttribute(&cus, hipDeviceAttributeMultiprocessorCount, dev);
        if (hipFuncSetAttribute((const void*)fwd_megakernel, hipFuncAttributeMaxDynamicSharedMemorySize, LDS_BYTES) != hipSuccess) { fprintf(stderr, "kernel_launch: hipFuncSetAttribute failed\n"); grid = -1; return; }
        if (hipOccupancyMaxActiveBlocksPerMultiprocessor(&per_cu, (const void*)fwd_megakernel, NWAVES * 64, LDS_BYTES) != hipSuccess || per_cu < 1) { fprintf(stderr, "kernel_launch: occupancy query gave %d\n", per_cu); per_cu = 1; }
        (void)hipGetLastError();
        grid = cus * per_cu;
        if (grid > 256) grid = 256;
    }
    if (grid < 0) return;
    (void)hipMemsetAsync((char*)d_ws + WS_BAR, 0, 16384, stream);
    Args a{};
    for (int i = 0; i < 21; ++i) a.in[i] = (const float*)d_in[i];
    a.out = (float*)d_out; a.ws = (unsigned char*)d_ws;
    void* kargs[] = {&a};
    hipError_t e = hipLaunchCooperativeKernel((const void*)fwd_megakernel, dim3(grid), dim3(NWAVES * 64), kargs, LDS_BYTES, stream);
    if (e != hipSuccess) fprintf(stderr, "cooperative launch failed: %s (grid %d)\n", hipGetErrorString(e), grid);
}
```

```cpp
#include <hip/hip_runtime.h>
#include <hip/hip_cooperative_groups.h>
#include <cstdint>
#include <cstdio>
namespace cg = cooperative_groups;

constexpr int Dm = 1024, NB = 8, SEQ = 4096, MT = NB * SEQ, FF = 2816;

__device__ __forceinline__ float sigm(float x) { return __builtin_amdgcn_rcpf(1.f + __expf(-x)); }
__device__ __forceinline__ float gelu_tanh(float y) {
    const float z = 0.7978845608028654f * (y + 0.044715f * y * y * y);
    return y * sigm(2.f * z);
}
__device__ __forceinline__ void sincos_d(double x, double& s, double& c) {
    const double q = rint(x * 0.63661977236758134308);
    double r = fma(-q, 1.57079632673412561417e+00, x);
    r = fma(-q, 6.07710050650619224932e-11, r);
    r = fma(-q, 2.02226624879595063154e-21, r);
    const double z = r * r;
    const double sp = r + r * z * (-1.66666666666666324348e-01 + z * (8.33333333332248946124e-03 + z * (-1.98412698298579493134e-04 + z * (2.75573137070700676789e-06 + z * (-2.50507602534068634195e-08 + z * 1.58969099521155010221e-10)))));
    const double cp = 1.0 - 0.5 * z + z * z * (4.16666666666666019037e-02 + z * (-1.38888888888741095749e-03 + z * (2.48015872894767294178e-05 + z * (-2.75573143513906633035e-07 + z * (2.08757232129817482790e-09 + z * -1.13596475577881948265e-11)))));
    const int qi = ((int)q) & 3;
    s = (qi == 0) ? sp : (qi == 1) ? cp : (qi == 2) ? -sp : -cp;
    c = (qi == 0) ? cp : (qi == 1) ? -sp : (qi == 2) ? -cp : sp;
}
struct SsmP { double abr, abi, qr, qi; };
__device__ __forceinline__ SsmP ssm_param(float a_re, float a_im, float log_step) {
    const double lr = fmin((double)a_re, -1e-4), li = (double)a_im, dt = exp((double)log_step);
    const double mag = exp(lr * dt);
    double sn, cs; sincos_d(li * dt, sn, cs);
    SsmP p; p.abr = mag * cs; p.abi = mag * sn;
    const double den = lr * lr + li * li;
    p.qr = ((p.abr - 1.0) * lr + p.abi * li) / den;
    p.qi = (p.abi * lr - (p.abr - 1.0) * li) / den;
    return p;
}
namespace pg8 {
#define PG8_LAS __attribute__((address_space(3)))
typedef unsigned short bf16_t;
typedef short bf16x8 __attribute__((ext_vector_type(8)));
typedef float f32x4 __attribute__((ext_vector_type(4)));
typedef unsigned u32x4 __attribute__((ext_vector_type(4)));
constexpr int BM = 256, BK = 64, HALF = 128, HTB = HALF * BK * 2  , STAGE_BYTES = 8 * HTB, NXCD = 8, WGM = 8;

__host__ __device__ __forceinline__ int lds_byte(int r, int c) { const int st = (r >> 4) * 2 + (c >> 5), rr = r & 15, cc = c & 31, ob = rr * 64 + cc * 2; return st * 1024 + (ob ^ (((ob >> 9) & 1) << 5)); }
__host__ __device__ __forceinline__ void stage_rc(int b, int& R, int& C) { const int st = b / 1024, sb = b % 1024, swz = sb ^ (((sb >> 9) & 1) << 5); R = (st >> 1) * 16 + swz / 64; C = (st & 1) * 32 + (swz % 64) / 2; }
__host__ __device__ __forceinline__ int perm32(int rho) { const int n = rho >> 4, i = rho & 15; return 8 * (i >> 2) + 4 * n + (i & 3); }

struct Unit { int pm, pn, ord; };
struct Gemm { const bf16_t* A; const bf16_t* Bt; int M, N, K; };

struct StaticOrder {
    int nM, nN, nwg, G, c;
    __host__ __device__ void init(int M, int N, int G_, int c_) { nM = M / BM; nN = N / BM; nwg = nM * nN; G = G_; c = c_; }
    __host__ __device__ bool next(int i, Unit& u) const {
        const long L = (long)i * G + c; if (L >= nwg) return false;
        int wgid = (int)L; { const int q = nwg / NXCD, r = nwg % NXCD, xcd = wgid % NXCD, off = wgid / NXCD; wgid = (xcd < r ? xcd * (q + 1) : r * (q + 1) + (xcd - r) * q) + off; }
        const int nig = WGM * nN, gid = wgid / nig, fm = gid * WGM, gsz = (nM - fm) < WGM ? (nM - fm) : WGM;
        u.pm = fm + ((wgid % nig) % gsz); u.pn = (wgid % nig) / gsz; u.ord = i; return true;
    }
    __device__ __forceinline__ void a_ready(const Unit&) const {}
    __device__ __forceinline__ void done(const Unit&) const {}
};

__device__ __forceinline__ unsigned cvt_pk_bf16(float lo, float hi) { unsigned r; asm volatile("v_cvt_pk_bf16_f32 %0, %1, %2" : "=v"(r) : "v"(lo), "v"(hi)); return r; }

__device__ __forceinline__ float sigm_(float x) { return __builtin_amdgcn_rcpf(1.f + __expf(-x)); }
template <int NS> __device__ __forceinline__ void phase_rstd(PG8_LAS float* rl, const float* slots, const StaticOrder& S) {
    int tid = threadIdx.x; asm volatile("" : "+v"(tid));
    const int nu = (S.nwg - S.c + S.G - 1) / S.G, row = tid & 255;
#pragma unroll 3
    for (int i = tid >> 8; i < nu; i += 2) {
        Unit u; S.next(i, u);
        const f32x4* p = (const f32x4*)(slots + (size_t)(u.pm * BM + row) * 32);
        f32x4 v[NS / 4];
#pragma unroll
        for (int q = 0; q < NS / 4; ++q) v[q] = p[q];
        float s = 0.f;
#pragma unroll
        for (int q = 0; q < NS / 4; ++q) s += (v[q][0] + v[q][1]) + (v[q][2] + v[q][3]);
        rl[i * 256 + row] = rsqrtf(s * (1.f / 1024.f) + 1e-6f);
    }
    __syncthreads();
}
__device__ __forceinline__ u32x4 pack8(const f32x4& a, const f32x4& b) {
    u32x4 w; w.x = cvt_pk_bf16(a[0], a[1]); w.y = cvt_pk_bf16(a[2], a[3]); w.z = cvt_pk_bf16(b[0], b[1]); w.w = cvt_pk_bf16(b[2], b[3]); return w;
}

template <int NS> struct EpiF1 {
    static constexpr bool PERM = true, AFTER_DRAIN = false;
    bf16_t* act; const float* bias; const float* slots; PG8_LAS float* rl;
    __device__ __forceinline__ void operator()(const f32x4 (&acc)[2][2][4][2], const Unit& u, int wr, int wc, int fr, int fq) const {
        asm volatile("" : "+v"(fr), "+v"(fq));
        const int row0 = u.pm * BM, b = u.pm >> 4, cl = wc * 32 + 8 * fq;
        const float* bp = bias + (size_t)b * 5632 + u.pn * 256 + cl;
        const f32x4 bg0 = *(const f32x4*)(bp), bg1 = *(const f32x4*)(bp + 4), bu0 = *(const f32x4*)(bp + 128), bu1 = *(const f32x4*)(bp + 132);
        const f32x4 bgn0 = bg0 * -1.4426950408889634f, bgn1 = bg1 * -1.4426950408889634f, bun0 = bu0 * -0.6931471805599453f, bun1 = bu1 * -0.6931471805599453f;
#pragma unroll
        for (int ai = 0; ai < 2; ++ai)
#pragma unroll
            for (int m = 0; m < 4; ++m) {
                const int rloc = ai * HALF + wr * 64 + m * 16 + fr; const float rs = rl[u.ord * 256 + rloc], rsn = rs * -1.4426950408889634f, rsu = rs * -0.6931471805599453f;
                const f32x4 n0 = acc[ai][0][m][0] * rsn + bgn0, n1 = acc[ai][0][m][1] * rsn + bgn1, u0 = acc[ai][1][m][0] * rsu + bun0, u1 = acc[ai][1][m][1] * rsu + bun1;
                f32x4 e0, e1;
#pragma unroll
                for (int j = 0; j < 4; ++j) { e0[j] = __builtin_amdgcn_exp2f(n0[j]); e1[j] = __builtin_amdgcn_exp2f(n1[j]); }
                e0 = e0 + 1.f; e1 = e1 + 1.f;
                f32x4 r0, r1;
#pragma unroll
                for (int j = 0; j < 4; ++j) { r0[j] = __builtin_amdgcn_rcpf(e0[j]); r1[j] = __builtin_amdgcn_rcpf(e1[j]); }
                const f32x4 o0 = (n0 * u0) * r0, o1 = (n1 * u1) * r1;
                *(u32x4*)(act + (size_t)(row0 + rloc) * 2816 + u.pn * 128 + cl) = pack8(o0, o1);
            }
    }
};

__device__ __forceinline__ void unpack8(const u32x4& w, f32x4& a, f32x4& b) {
    a[0] = __builtin_bit_cast(float, w.x << 16); a[1] = __builtin_bit_cast(float, w.x & 0xffff0000u); a[2] = __builtin_bit_cast(float, w.y << 16); a[3] = __builtin_bit_cast(float, w.y & 0xffff0000u);
    b[0] = __builtin_bit_cast(float, w.z << 16); b[1] = __builtin_bit_cast(float, w.z & 0xffff0000u); b[2] = __builtin_bit_cast(float, w.w << 16); b[3] = __builtin_bit_cast(float, w.w & 0xffff0000u);
}
template <bool XF32> struct EpiGluRes {
    static constexpr bool PERM = true, AFTER_DRAIN = false;
    const float* xin; const bf16_t* xbin; bf16_t* xb; bf16_t* xs; const float* gate_v; const float* gsg; const float* gsc; float* slots;
    __device__ __forceinline__ void operator()(const f32x4 (&acc)[2][2][4][2], const Unit& u, int wr, int wc, int fr, int fq) const {
        asm volatile("" : "+v"(fr), "+v"(fq));
        const int row0 = u.pm * BM, b = u.pm >> 4, col = u.pn * 128 + wc * 32 + 8 * fq;
        const f32x4 gt0 = *(const f32x4*)(gate_v + (size_t)b * 6144 + col), gt1 = *(const f32x4*)(gate_v + (size_t)b * 6144 + col + 4);
        const f32x4 gs0 = *(const f32x4*)(gsg + col) * (*(const f32x4*)(gsc + (size_t)b * 6144 + col) + 1.f);
        const f32x4 gs1 = *(const f32x4*)(gsg + col + 4) * (*(const f32x4*)(gsc + (size_t)b * 6144 + col + 4) + 1.f);
#pragma unroll
        for (int ai = 0; ai < 2; ++ai) {
            f32x4 xf[4][2]; u32x4 xv[4];
#pragma unroll
            for (int m = 0; m < 4; ++m) {
                const size_t row = (size_t)(row0 + ai * HALF + wr * 64 + m * 16 + fr);
                if (XF32) { xf[m][0] = __builtin_nontemporal_load((const f32x4*)(xin + row * 1024 + col)); xf[m][1] = __builtin_nontemporal_load((const f32x4*)(xin + row * 1024 + col + 4)); }
                else xv[m] = *(const u32x4*)(xbin + row * 1024 + col);
            }
#pragma unroll
            for (int m = 0; m < 4; ++m) {
                const size_t row = (size_t)(row0 + ai * HALF + wr * 64 + m * 16 + fr);
                f32x4 x0, x1;
                if (XF32) { x0 = xf[m][0]; x1 = xf[m][1]; } else unpack8(xv[m], x0, x1);
                const f32x4 a0 = acc[ai][1][m][0] * -1.4426950408889634f, a1 = acc[ai][1][m][1] * -1.4426950408889634f;
                f32x4 e0, e1;
#pragma unroll
                for (int j = 0; j < 4; ++j) { e0[j] = __builtin_amdgcn_exp2f(a0[j]); e1[j] = __builtin_amdgcn_exp2f(a1[j]); }
                e0 = e0 + 1.f; e1 = e1 + 1.f;
                f32x4 r0, r1;
#pragma unroll
                for (int j = 0; j < 4; ++j) { r0[j] = __builtin_amdgcn_rcpf(e0[j]); r1[j] = __builtin_amdgcn_rcpf(e1[j]); }
                const f32x4 n0 = x0 + gt0 * (acc[ai][0][m][0] * r0), n1 = x1 + gt1 * (acc[ai][0][m][1] * r1);
                *(u32x4*)(xb + row * 1024 + col) = pack8(n0, n1);
                *(u32x4*)(xs + row * 1024 + col) = pack8(n0 * gs0, n1 * gs1);
                float ss = ((n0[0] * n0[0] + n0[1] * n0[1]) + (n0[2] * n0[2] + n0[3] * n0[3])) + ((n1[0] * n1[0] + n1[1] * n1[1]) + (n1[2] * n1[2] + n1[3] * n1[3]));
                ss += __shfl_xor(ss, 16); ss += __shfl_xor(ss, 32);
                if (fq == 0) slots[row * 32 + u.pn * 4 + wc] = ss;
            }
        }
    }
};

template <bool LAST> struct EpiRes {
    static constexpr bool PERM = true, AFTER_DRAIN = false;
    const bf16_t* xbin; bf16_t* xb; float* xout; bf16_t* xs; const float* gate_v; const float* gsg; const float* gsc; float* slots;
    __device__ __forceinline__ void operator()(const f32x4 (&acc)[2][2][4][2], const Unit& u, int wr, int wc, int fr, int fq) const {
        asm volatile("" : "+v"(fr), "+v"(fq));
        const int row0 = u.pm * BM, b = u.pm >> 4, col = u.pn * 256 + wc * 32 + 8 * fq;
        f32x4 gt[2][2], gs[2][2];
#pragma unroll
        for (int bj = 0; bj < 2; ++bj)
#pragma unroll
            for (int n = 0; n < 2; ++n) {
                const int c = col + bj * HALF + 4 * n;
                gt[bj][n] = *(const f32x4*)(gate_v + (size_t)b * 6144 + c);
                if (!LAST) gs[bj][n] = *(const f32x4*)(gsg + c) * (*(const f32x4*)(gsc + (size_t)b * 6144 + c) + 1.f);
            }
#pragma unroll
        for (int ai = 0; ai < 2; ++ai) {
            u32x4 xv[4][2];
#pragma unroll
            for (int m = 0; m < 4; ++m)
#pragma unroll
                for (int bj = 0; bj < 2; ++bj) xv[m][bj] = *(const u32x4*)(xbin + (size_t)(row0 + ai * HALF + wr * 64 + m * 16 + fr) * 1024 + col + bj * HALF);
#pragma unroll
            for (int m = 0; m < 4; ++m) {
                const size_t row = (size_t)(row0 + ai * HALF + wr * 64 + m * 16 + fr);
                float ss = 0.f;
#pragma unroll
                for (int bj = 0; bj < 2; ++bj) {
                    const size_t o = row * 1024 + col + bj * HALF;
                    f32x4 x0, x1; unpack8(xv[m][bj], x0, x1);
                    const f32x4 n0 = x0 + gt[bj][0] * acc[ai][bj][m][0], n1 = x1 + gt[bj][1] * acc[ai][bj][m][1];
                    if (LAST) { *(f32x4*)(xout + o) = n0; *(f32x4*)(xout + o + 4) = n1; }
                    else { *(u32x4*)(xb + o) = pack8(n0, n1); *(u32x4*)(xs + o) = pack8(n0 * gs[bj][0], n1 * gs[bj][1]); }
                    ss += ((n0[0] * n0[0] + n0[1] * n0[1]) + (n0[2] * n0[2] + n0[3] * n0[3])) + ((n1[0] * n1[0] + n1[1] * n1[1]) + (n1[2] * n1[2] + n1[3] * n1[3]));
                }
                ss += __shfl_xor(ss, 16); ss += __shfl_xor(ss, 32);
                if (fq == 0) slots[row * 32 + u.pn * 4 + wc] = ss;
            }
        }
    }
};

struct EpiCV {
    static constexpr bool PERM = true, AFTER_DRAIN = false;
    bf16_t* cv; const float* bias; PG8_LAS float* rl;
    __device__ __forceinline__ void operator()(const f32x4 (&acc)[2][2][4][2], const Unit& u, int wr, int wc, int fr, int fq) const {
        asm volatile("" : "+v"(fr), "+v"(fq));
        const int row0 = u.pm * BM, b = u.pm >> 4, cl = wc * 32 + 8 * fq;
        const float* bp = bias + (size_t)b * 3072 + u.pn * 256 + cl;
        const f32x4 b00 = *(const f32x4*)(bp), b01 = *(const f32x4*)(bp + 4), b10 = *(const f32x4*)(bp + 128), b11 = *(const f32x4*)(bp + 132);
#pragma unroll
        for (int ai = 0; ai < 2; ++ai)
#pragma unroll
            for (int m = 0; m < 4; ++m) {
                const int rloc = ai * HALF + wr * 64 + m * 16 + fr; const float rs = rl[u.ord * 256 + rloc];
                const f32x4 v00 = acc[ai][0][m][0] * rs + b00, v01 = acc[ai][0][m][1] * rs + b01, v10 = acc[ai][1][m][0] * rs + b10, v11 = acc[ai][1][m][1] * rs + b11;
                *(u32x4*)(cv + (size_t)(row0 + rloc) * 1024 + u.pn * 128 + cl) = pack8(v00 * v10, v01 * v11);
            }
    }
};
struct EpiBGP {
    static constexpr bool PERM = true, AFTER_DRAIN = false;
    const bf16_t* cv; bf16_t* p; const float* bias; const float* cw; PG8_LAS float* rl;
    __device__ __forceinline__ void operator()(const f32x4 (&acc)[2][2][4][2], const Unit& u, int wr, int wc, int fr, int fq) const {
        asm volatile("" : "+v"(fr), "+v"(fq));
        const int row0 = u.pm * BM, b = u.pm >> 4;
#pragma unroll
        for (int bj = 0; bj < 2; ++bj) {
            const int col = u.pn * 256 + bj * HALF + wc * 32 + 8 * fq;
            const float* bp = bias + (size_t)b * 3072 + 2048 + col;
            const f32x4 bb0 = *(const f32x4*)(bp), bb1 = *(const f32x4*)(bp + 4);
            const f32x4 w00 = *(const f32x4*)(cw + col), w01 = *(const f32x4*)(cw + col + 4), w10 = *(const f32x4*)(cw + 1024 + col), w11 = *(const f32x4*)(cw + 1024 + col + 4),
                        w20 = *(const f32x4*)(cw + 2048 + col), w21 = *(const f32x4*)(cw + 2048 + col + 4);
#pragma unroll
            for (int ah = 0; ah < 4; ++ah) {
                const int ai = ah >> 1, mb = (ah & 1) * 2;
                u32x4 q[2][3];
#pragma unroll
                for (int mm = 0; mm < 2; ++mm) {
                    const size_t row = (size_t)(row0 + ai * HALF + wr * 64 + (mb + mm) * 16 + fr); const int t = (int)(row & 4095);
                    const bf16_t* cp = cv + row * 1024 + col;
                    const u32x4 z = {0u, 0u, 0u, 0u};
                    q[mm][0] = *(const u32x4*)(cp); q[mm][1] = (t >= 1) ? *(const u32x4*)(cp - 1024) : z; q[mm][2] = (t >= 2) ? *(const u32x4*)(cp - 2048) : z;
                }
#pragma unroll
                for (int mm = 0; mm < 2; ++mm) {
                    const int m = mb + mm;
                    const int rloc = ai * HALF + wr * 64 + m * 16 + fr; const float rs = rl[u.ord * 256 + rloc];
                    const size_t row = (size_t)(row0 + rloc);
                    f32x4 c00, c01, c10, c11, c20, c21; unpack8(q[mm][0], c00, c01); unpack8(q[mm][1], c10, c11); unpack8(q[mm][2], c20, c21);
                    const f32x4 g0 = acc[ai][bj][m][0] * rs + bb0, g1 = acc[ai][bj][m][1] * rs + bb1;
                    const f32x4 cv0 = w20 * c00 + w10 * c10 + w00 * c20, cv1 = w21 * c01 + w11 * c11 + w01 * c21;
                    *(u32x4*)(p + row * 1024 + col) = pack8(g0 * cv0, g1 * cv1);
                }
            }
        }
    }
};

struct EpiNull {
    static constexpr bool PERM = true, AFTER_DRAIN = false;
    float* sink;
    __device__ __forceinline__ void operator()(const f32x4 (&acc)[2][2][4][2], const Unit& u, int wr, int wc, int fr, int fq) const {
        float s = 0.f;
#pragma unroll
        for (int ai = 0; ai < 2; ++ai)
#pragma unroll
            for (int bj = 0; bj < 2; ++bj)
#pragma unroll
                for (int m = 0; m < 4; ++m)
#pragma unroll
                    for (int n = 0; n < 2; ++n) s += (acc[ai][bj][m][n][0] + acc[ai][bj][m][n][1]) + (acc[ai][bj][m][n][2] + acc[ai][bj][m][n][3]);
        if (s == 1.2345e30f) sink[0] = s;
    }
};
template <class Epi, class Sched, bool ALIGN_EPI = false, bool SP2 = false>
__device__ __forceinline__ void gemm_phase(PG8_LAS unsigned char* lds, const Gemm g, const Sched& S, const Epi& E) {
    int tid_ = threadIdx.x; asm volatile("" : "+v"(tid_));
    const int tid = tid_, wid = __builtin_amdgcn_readfirstlane(tid >> 6), lane = tid & 63, wr = wid >> 2, wc = wid & 3, fr = lane & 15, fq = lane >> 4;
    const int K = g.K, nt = K / BK;
    unsigned voffA[2], voffB[2];
#pragma unroll
    for (int i = 0; i < 2; ++i) { int R, C; stage_rc(tid * 16 + i * 8192, R, C); const int Rb = Epi::PERM ? ((R & ~31) + perm32(R & 31)) : R;
        voffA[i] = (unsigned)(R * K + C) * 2u; voffB[i] = (unsigned)(Rb * K + C) * 2u; }
    const size_t kstep = (size_t)(BK * 2);
    const size_t hstep = (size_t)HALF * K * 2;
    const size_t tstep = 2 * hstep;
    const unsigned ldsw = (unsigned)wid * 1024u;
    const int aoff = lds_byte(wr * 64 + fr, fq * 8), boff = lds_byte(wc * 32 + fr, fq * 8);
#define PG8_SA(b, h) (((b) * 2 + (h)) * HTB)
#define PG8_SB(b, h) ((4 + (b) * 2 + (h)) * HTB)
#define PG8_STAGE(bufoff, gbase, voff) do { _Pragma("unroll") for (int _i = 0; _i < 2; ++_i) \
        __builtin_amdgcn_global_load_lds((const unsigned*)((const char*)(gbase) + (voff)[_i]), (PG8_LAS unsigned*)(lds + (bufoff) + ldsw + _i * 8192), 16, 0, 0); } while (0)
#define PG8_LDA(dst, b, h) do { _Pragma("unroll") for (int m = 0; m < 4; ++m) _Pragma("unroll") for (int k = 0; k < 2; ++k) dst[m][k] = *(const PG8_LAS bf16x8*)(lds + PG8_SA(b, h) + aoff + m * 2048 + k * 1024); } while (0)
#define PG8_LDB(dst, b, h) do { _Pragma("unroll") for (int n = 0; n < 2; ++n) _Pragma("unroll") for (int k = 0; k < 2; ++k) dst[n][k] = *(const PG8_LAS bf16x8*)(lds + PG8_SB(b, h) + boff + n * 2048 + k * 1024); } while (0)
#define PG8_MMA(ai, bj, At, Bt) do { __builtin_amdgcn_s_setprio(1); _Pragma("unroll") for (int m = 0; m < 4; ++m) _Pragma("unroll") for (int n = 0; n < 2; ++n) _Pragma("unroll") for (int k = 0; k < 2; ++k) \
        acc[ai][bj][m][n] = __builtin_amdgcn_mfma_f32_16x16x32_bf16(Bt[n][k], At[m][k], acc[ai][bj][m][n], 0, 0, 0); __builtin_amdgcn_s_setprio(0); } while (0)
#define PG8_WAIT_V(n) asm volatile("s_waitcnt vmcnt(" #n ")" ::: "memory")
#define PG8_WAIT_L(n) asm volatile("s_waitcnt lgkmcnt(" #n ")" ::: "memory")
#define PG8_BAR __builtin_amdgcn_s_barrier()
#define PG8_SCHED __builtin_amdgcn_sched_barrier(0)
    Unit cur, nxt; int ui = 0;
    if (!S.next(0, cur)) return;
    f32x4 acc[2][2][4][2];
#pragma unroll
    for (int a = 0; a < 2; ++a)
#pragma unroll
        for (int b = 0; b < 2; ++b)
#pragma unroll
            for (int m = 0; m < 4; ++m)
#pragma unroll
                for (int n = 0; n < 2; ++n) acc[a][b][m][n] = (f32x4){0.f, 0.f, 0.f, 0.f};
    bf16x8 At[4][2], B0[2][2], B1[2][2];
    const char* cA = (const char*)g.A + (size_t)cur.pm * tstep; const char* cB = (const char*)g.Bt + (size_t)cur.pn * tstep;
    S.a_ready(cur);
    if constexpr (SP2) {
        PG8_STAGE(PG8_SB(0, 0), cB, voffB); PG8_STAGE(PG8_SB(0, 1), cB + hstep, voffB); PG8_STAGE(PG8_SA(0, 0), cA, voffA); PG8_STAGE(PG8_SA(0, 1), cA + hstep, voffA);
        if (wr == 1) PG8_BAR;
        PG8_WAIT_V(2); PG8_BAR;
        PG8_STAGE(PG8_SB(1, 0), cB + kstep, voffB); PG8_STAGE(PG8_SA(1, 0), cA + kstep, voffA); PG8_STAGE(PG8_SB(1, 1), cB + hstep + kstep, voffB);
        PG8_WAIT_V(6); PG8_BAR;
    } else {
        PG8_STAGE(PG8_SB(0, 0), cB, voffB); PG8_STAGE(PG8_SA(0, 0), cA, voffA); PG8_STAGE(PG8_SB(0, 1), cB + hstep, voffB); PG8_STAGE(PG8_SA(0, 1), cA + hstep, voffA);
        if (wr == 1) PG8_BAR;
        PG8_WAIT_V(4); PG8_BAR;
        PG8_STAGE(PG8_SB(1, 0), cB + kstep, voffB); PG8_STAGE(PG8_SA(1, 0), cA + kstep, voffA); PG8_STAGE(PG8_SB(1, 1), cB + hstep + kstep, voffB);
        PG8_WAIT_V(6); PG8_BAR;
    }
    for (;;) {
        const bool has_next = S.next(ui + 1, nxt);
        const char* nA = has_next ? (const char*)g.A + (size_t)nxt.pm * tstep : cA; const char* nB = has_next ? (const char*)g.Bt + (size_t)nxt.pn * tstep : cB;
        for (int t = 0; t < nt; t += 2) {
            const bool last = (t == nt - 2);
            const char* a1 = cA + (size_t)(t + 1) * kstep;
            const char* a2 = last ? nA : cA + (size_t)(t + 2) * kstep; const char* b2 = last ? nB : cB + (size_t)(t + 2) * kstep;
            const char* a3 = a2 + kstep; const char* b3 = b2 + kstep;
            if (last && has_next) S.a_ready(nxt);
            if constexpr (SP2) {
            PG8_LDB(B0, 0, 0); PG8_LDB(B1, 0, 1); PG8_SCHED; PG8_LDA(At, 0, 0); PG8_STAGE(PG8_SA(1, 1), a1 + hstep, voffA);
            PG8_WAIT_V(8); PG8_WAIT_L(0); PG8_BAR; PG8_MMA(0, 0, At, B0); PG8_MMA(0, 1, At, B1); PG8_BAR; PG8_SCHED;
            PG8_LDA(At, 0, 1); PG8_STAGE(PG8_SB(0, 0), b2, voffB); PG8_STAGE(PG8_SB(0, 1), b2 + hstep, voffB); PG8_STAGE(PG8_SA(0, 0), a2, voffA);
            PG8_WAIT_V(8); PG8_WAIT_L(0); PG8_BAR; PG8_MMA(1, 0, At, B0); PG8_MMA(1, 1, At, B1); PG8_BAR; PG8_SCHED;
            PG8_LDB(B0, 1, 0); PG8_LDB(B1, 1, 1); PG8_SCHED; PG8_LDA(At, 1, 0); PG8_STAGE(PG8_SA(0, 1), a2 + hstep, voffA);
            PG8_WAIT_V(8); PG8_WAIT_L(0); PG8_BAR; PG8_MMA(0, 0, At, B0); PG8_MMA(0, 1, At, B1); PG8_BAR; PG8_SCHED;
            PG8_LDA(At, 1, 1); PG8_STAGE(PG8_SB(1, 0), b3, voffB); PG8_STAGE(PG8_SB(1, 1), b3 + hstep, voffB); PG8_STAGE(PG8_SA(1, 0), a3, voffA);
            PG8_WAIT_V(8); PG8_WAIT_L(0); PG8_BAR; PG8_MMA(1, 0, At, B0); PG8_MMA(1, 1, At, B1); PG8_BAR; PG8_SCHED;
            } else {
            PG8_LDB(B0, 0, 0); PG8_SCHED; PG8_LDA(At, 0, 0); PG8_STAGE(PG8_SA(1, 1), a1 + hstep, voffA);
            PG8_WAIT_L(8); PG8_BAR; PG8_WAIT_L(0); PG8_MMA(0, 0, At, B0); PG8_BAR; PG8_SCHED;
            PG8_LDB(B1, 0, 1); PG8_STAGE(PG8_SB(0, 0), b2, voffB);
            PG8_BAR; PG8_WAIT_L(0); PG8_MMA(0, 1, At, B1); PG8_BAR;
            PG8_LDA(At, 0, 1); PG8_STAGE(PG8_SA(0, 0), a2, voffA);
            PG8_BAR; PG8_WAIT_L(0); PG8_MMA(1, 0, At, B0); PG8_BAR; PG8_SCHED;
            PG8_STAGE(PG8_SB(0, 1), b2 + hstep, voffB);
            PG8_WAIT_V(6); PG8_BAR; PG8_MMA(1, 1, At, B1); PG8_BAR;
            PG8_LDB(B0, 1, 0); PG8_SCHED; PG8_LDA(At, 1, 0); PG8_STAGE(PG8_SA(0, 1), a2 + hstep, voffA);
            PG8_WAIT_L(8); PG8_BAR; PG8_WAIT_L(0); PG8_MMA(0, 0, At, B0); PG8_BAR; PG8_SCHED;
            PG8_LDB(B1, 1, 1); PG8_STAGE(PG8_SB(1, 0), b3, voffB);
            PG8_BAR; PG8_WAIT_L(0); PG8_MMA(0, 1, At, B1); PG8_BAR;
            PG8_LDA(At, 1, 1); PG8_STAGE(PG8_SA(1, 0), a3, voffA);
            PG8_BAR; PG8_WAIT_L(0); PG8_MMA(1, 0, At, B0); PG8_BAR; PG8_SCHED;
            PG8_STAGE(PG8_SB(1, 1), b3 + hstep, voffB);
            PG8_WAIT_V(6); PG8_BAR; PG8_MMA(1, 1, At, B1); PG8_BAR;
            }
        }
        if constexpr (ALIGN_EPI) { if (wr == 0) PG8_BAR; }
        if constexpr (!Epi::AFTER_DRAIN) { E(acc, cur, wr, wc, fr, fq); S.done(cur); }
        if (!has_next) break;
#pragma unroll
        for (int a = 0; a < 2; ++a)
#pragma unroll
            for (int b = 0; b < 2; ++b)
#pragma unroll
                for (int m = 0; m < 4; ++m)
#pragma unroll
                    for (int n = 0; n < 2; ++n) acc[a][b][m][n] = (f32x4){0.f, 0.f, 0.f, 0.f};
        cur = nxt; cA = nA; cB = nB; ++ui;
        if constexpr (ALIGN_EPI) { if (wr == 1) PG8_BAR; }
    }
    PG8_WAIT_V(0);
    if constexpr (!ALIGN_EPI) { if (wr == 0) PG8_BAR; }
    PG8_BAR;
    if constexpr (Epi::AFTER_DRAIN) { E.fused(acc, cur, wr, wc, fr, fq, lds, wid, lane); S.done(cur); }
#undef PG8_SA
#undef PG8_SB
#undef PG8_STAGE
#undef PG8_LDA
#undef PG8_LDB
#undef PG8_MMA
#undef PG8_WAIT_V
#undef PG8_WAIT_L
#undef PG8_BAR
#undef PG8_SCHED
}
}

#define LAS __attribute__((address_space(3)))
typedef unsigned short bf16;
typedef unsigned v4u __attribute__((ext_vector_type(4)));
typedef unsigned v2u __attribute__((ext_vector_type(2)));
typedef float f32x4 __attribute__((ext_vector_type(4)));
typedef float f32x16 __attribute__((ext_vector_type(16)));
typedef float f32x2v __attribute__((ext_vector_type(2)));
typedef short bf16x8 __attribute__((ext_vector_type(8)));
#define MFMA32(a, b, c) __builtin_amdgcn_mfma_f32_32x32x16_bf16((a), (b), (c), 0, 0, 0)
#define LDS_WAIT() asm volatile("s_waitcnt lgkmcnt(0)" ::: "memory")

constexpr size_t MiB = 1u << 20;
constexpr size_t WS_WT_SSM = 0, WS_WT_CIN = 8 * MiB, WS_WT_COUT = 20 * MiB, WS_WT_FIN = 24 * MiB, WS_WT_FOUT = 68 * MiB;
constexpr size_t WS_MODS = 90 * MiB, WS_BIAS_F1 = 91 * MiB, WS_BIAS_C1 = 92 * MiB, WS_BOP = 93 * MiB, WS_COP = 94 * MiB, WS_AV = 95 * MiB, WS_AP = 95 * MiB + 65536, WS_BAR = 95 * MiB + 131072;
constexpr size_t WS_SLOTS = 96 * MiB, WS_XS = 100 * MiB, WS_R = 164 * MiB, WS_XB = 340 * MiB, WS_POP = 404 * MiB, WS_TOP = 406 * MiB, WS_QOP = 407 * MiB, WS_END = 409 * MiB;
constexpr size_t WS_NEED = WS_END;
constexpr int NWAVES = 8;
constexpr int STAGE_LDS = 131072, MISC_LDS = STAGE_LDS + 16384, LDS_BYTES = MISC_LDS + 64;

typedef float f32x2_t __attribute__((ext_vector_type(2)));
typedef __bf16 bf16x2_t __attribute__((ext_vector_type(2)));
__device__ __forceinline__ unsigned pk2(float lo, float hi) { const f32x2_t v = {lo, hi}; const bf16x2_t b = __builtin_convertvector(v, bf16x2_t); return __builtin_bit_cast(unsigned, b); }
#define WAVE_LDS_SYNC() do { __builtin_amdgcn_fence(__ATOMIC_RELEASE, "wavefront"); __builtin_amdgcn_wave_barrier(); __builtin_amdgcn_fence(__ATOMIC_ACQUIRE, "wavefront"); } while (0)
__device__ __forceinline__ float bf_lo(unsigned u) { return __builtin_bit_cast(float, u << 16); }
__device__ __forceinline__ float bf_hi(unsigned u) { return __builtin_bit_cast(float, u & 0xffff0000u); }
__device__ __forceinline__ float gelu_fast(float y) {
    const float t = y * y, u = y * __builtin_fmaf(t, -0.10294324f, -2.3022082f);
    return y * __builtin_amdgcn_rcpf(1.f + __builtin_amdgcn_exp2f(u));
}
__device__ __forceinline__ float wave_sum(float v) {
#pragma unroll
    for (int o = 1; o < 64; o <<= 1) v += __shfl_xor(v, o);
    return v;
}

#define XB_TMO      128
#define XB_XCNT(j)  (256  + 64 * (j))
#define XB_XSUB(j)  (1280 + 64 * (j))
#define XB_XGEN(j)  (2304 + 64 * (j))
#define XB_TOP      3328
#define XB_TOPGEN   3392
#define XCD_BAR_WORDS 3456
#define XB_SPIN_CAP (1u << 18)

__device__ __forceinline__ unsigned xb_ld(unsigned* p)              { return __hip_atomic_load(p, __ATOMIC_RELAXED, __HIP_MEMORY_SCOPE_AGENT); }
__device__ __forceinline__ unsigned xb_add(unsigned* p, unsigned v) { return __hip_atomic_fetch_add(p, v, __ATOMIC_RELAXED, __HIP_MEMORY_SCOPE_AGENT); }
__device__ __forceinline__ unsigned xb_xcc_id() { return (unsigned)__builtin_amdgcn_s_getreg((3 << 11) | 20) & 0xFu; }
#define XB_SPIN(cond, bar) do { unsigned _sp = 0; while (cond) { __builtin_amdgcn_s_sleep(1); \
    if ((++_sp & 255u) == 0u) { if (xb_ld(&(bar)[XB_TMO])) break; if (_sp > XB_SPIN_CAP) { atomicAdd(&(bar)[XB_TMO], 1u); break; } } } } while (0)

struct XcdBarrier {
    unsigned* bar; unsigned x;
    volatile LAS unsigned* st;
};

__device__ __forceinline__ XcdBarrier xcd_barrier_post(unsigned* bar, volatile LAS unsigned* st) {
    XcdBarrier b; b.bar = bar; b.x = xb_xcc_id(); b.st = st;
    if (threadIdx.x == 0) (void)xb_add(&bar[XB_XCNT(b.x)], 1u);
    return b;
}
__device__ __forceinline__ void xcd_barrier_complete(unsigned* bar, unsigned x, unsigned& nloc, unsigned& nx) {
    const unsigned G = gridDim.x * gridDim.y * gridDim.z;
    unsigned sum, cnt, mine, sp = 0u;
    for (;;) {
        sum = 0u; cnt = 0u; mine = 0u;
#pragma unroll
        for (unsigned j = 0; j < 16; ++j) { const unsigned c = xb_ld(&bar[XB_XCNT(j)]); sum += c; cnt += (c > 0u) ? 1u : 0u; mine = (j == x) ? c : mine; }
        if (sum == G) break;
        __builtin_amdgcn_s_sleep(1);
        if ((++sp & 255u) == 0u) { if (xb_ld(&bar[XB_TMO])) break; if (sp > XB_SPIN_CAP) { atomicAdd(&bar[XB_TMO], 1u); break; } }
    }
    nloc = mine > 0u ? mine : 1u; nx = cnt > 0u ? cnt : 1u;
}

__device__ __forceinline__ void xcd_barrier(const XcdBarrier& b) {
    asm volatile("s_waitcnt vmcnt(0)" ::: "memory");
    __syncthreads();
    if (threadIdx.x == 0) {
        unsigned* bar = b.bar; unsigned bx_ = b.x; asm volatile("" : "+s"(bx_));
        __builtin_amdgcn_s_waitcnt(0);
        unsigned nloc = b.st[0], nx = b.st[1];
        if (nloc == 0u) { xcd_barrier_complete(bar, bx_, nloc, nx); b.st[0] = nloc; b.st[1] = nx; }
        const unsigned old = xb_add(&bar[XB_XSUB(bx_)], 1u);
        const unsigned gen = old / nloc;
        if (old + 1u == (gen + 1u) * nloc) {
            __builtin_amdgcn_fence(__ATOMIC_RELEASE, "agent");
            asm volatile("s_waitcnt vmcnt(0)" ::: "memory");
            const unsigned og = xb_add(&bar[XB_TOP], 1u);
            const unsigned tg = og / nx;
            if (og + 1u == (tg + 1u) * nx) xb_add(&bar[XB_TOPGEN], 1u);
            else XB_SPIN(xb_ld(&bar[XB_TOPGEN]) == tg, bar);
            __builtin_amdgcn_fence(__ATOMIC_ACQUIRE, "agent");
            xb_add(&bar[XB_XGEN(bx_)], 1u);
            asm volatile("s_waitcnt vmcnt(0)" ::: "memory");
        } else {
            XB_SPIN(xb_ld(&bar[XB_XGEN(bx_)]) == gen, bar);
            __builtin_amdgcn_fence(__ATOMIC_ACQUIRE, "agent");
            asm volatile("s_waitcnt vmcnt(0)" ::: "memory");
        }
    }
    __syncthreads();
}

__device__ __forceinline__ void transpose_item(const float* __restrict__ W, int K, int N, bf16* WT, int mode, LAS float* scr, int item, int lane) {
    const int nblk = N / 32, kb = item / nblk, nb = item % nblk, k0 = 64 * kb, n0 = 32 * nb;
    int d0 = n0;
    if (mode == 1) { const int hN = N >> 1; if (n0 < hN) d0 = 256 * (n0 >> 7) + (n0 & 127); else { const int mm = n0 - hN; d0 = 256 * (mm >> 7) + 128 + (mm & 127); } }
    else if (mode == 2) { if (n0 < 1024) d0 = 2048 + n0; else if (n0 < 2048) { const int mm = n0 - 1024; d0 = 256 * (mm >> 7) + (mm & 127); } else { const int mm = n0 - 2048; d0 = 256 * (mm >> 7) + 128 + (mm & 127); } }
    float tv[32];
#pragma unroll
    for (int i = 0; i < 32; ++i) tv[i] = __builtin_nontemporal_load(W + (size_t)(k0 + 2 * i + (lane >> 5)) * N + n0 + (lane & 31));
#pragma unroll
    for (int i = 0; i < 32; ++i) scr[(2 * i + (lane >> 5)) * 33 + (lane & 31)] = tv[i];
    LDS_WAIT();
    const int c = lane & 7;
#pragma unroll
    for (int j = 0; j < 4; ++j) { const int n = (lane >> 3) + 8 * j; const LAS float* s = scr + (8 * c) * 33 + n;
        v4u o; o.x = pk2(s[0 * 33], s[1 * 33]); o.y = pk2(s[2 * 33], s[3 * 33]); o.z = pk2(s[4 * 33], s[5 * 33]); o.w = pk2(s[6 * 33], s[7 * 33]);
        *(v4u*)(WT + (size_t)(d0 + n) * K + k0 + 8 * c) = o; }
    LDS_WAIT();
}

struct Args { const float* in[21]; float* out; unsigned char* ws; };

struct Ctx {
    LAS unsigned char* lds; int tid, lane, wave, G, vcu, gw, NGW;
    const float *x, *c, *norm1_g, *norm2_g, *w_ada, *b_ada, *a_re, *a_im, *log_step, *b_re, *b_im, *c_re, *c_im, *ssm_d, *ssm_w_out, *conv_w_in, *conv_w, *conv_w_out, *w_ffn_in, *w_ffn_out, *final_g;
    float* out; unsigned char* ws;
};

__device__ __forceinline__ void p0a(Ctx& F) {
    int ptid_ = threadIdx.x; asm volatile("" : "+v"(ptid_)); const int plane_ = ptid_ & 63;
    float* mods = (float*)(F.ws + WS_MODS);
    LAS float* cT = (LAS float*)F.lds;
    LAS float* red = (LAS float*)(F.lds + 32768);
    for (int idx = ptid_; idx < 8192; idx += 512) { const int b = idx >> 10, k = idx & 1023; const float cv = F.c[idx]; cT[k * 8 + b] = cv * sigm(cv); }
    __syncthreads();
    for (int it = blockIdx.x; it < 256; it += F.G) {
        const int layer = it >> 6, n0 = (it & 63) * 96;
        float a0[8], a1[8];
#pragma unroll
        for (int b = 0; b < 8; ++b) { a0[b] = 0.f; a1[b] = 0.f; }
        if (plane_ < 48) {
            const float* wp = F.w_ada + ((size_t)layer * 1024 + F.wave * 128) * 6144 + n0 + 2 * plane_;
#pragma unroll 16
            for (int k = 0; k < 128; ++k) {
                float2 wv; wv.x = __builtin_nontemporal_load(wp + (size_t)k * 6144); wv.y = __builtin_nontemporal_load(wp + (size_t)k * 6144 + 1);
                const f32x4 c0 = *(const LAS f32x4*)(cT + (F.wave * 128 + k) * 8), c1 = *(const LAS f32x4*)(cT + (F.wave * 128 + k) * 8 + 4);
#pragma unroll
                for (int b = 0; b < 4; ++b) { a0[b] += c0[b] * wv.x; a1[b] += c0[b] * wv.y; a0[4 + b] += c1[b] * wv.x; a1[4 + b] += c1[b] * wv.y; }
            }
#pragma unroll
            for (int b = 0; b < 8; ++b) { red[(F.wave * 8 + b) * 96 + 2 * plane_] = a0[b]; red[(F.wave * 8 + b) * 96 + 2 * plane_ + 1] = a1[b]; }
        }
        __syncthreads();
        for (int idx = ptid_; idx < 768; idx += 512) {
            const int b = idx / 96, cc = idx % 96;
            float s = F.b_ada[layer * 6144 + n0 + cc];
#pragma unroll
            for (int w = 0; w < 8; ++w) s += red[(w * 8 + b) * 96 + cc];
            mods[((size_t)layer * 8 + b) * 6144 + n0 + cc] = s;
        }
        __syncthreads();
    }
    {
        LAS float* scr = (LAS float*)(F.lds + F.wave * 16384);
        bf16* wt_ssm = (bf16*)(F.ws + WS_WT_SSM); bf16* wt_cin = (bf16*)(F.ws + WS_WT_CIN); bf16* wt_cout = (bf16*)(F.ws + WS_WT_COUT);
        bf16* wt_fin = (bf16*)(F.ws + WS_WT_FIN); bf16* wt_fout = (bf16*)(F.ws + WS_WT_FOUT);
        constexpr int NITEMS = 2 * 1024 + 2 * 1536 + 2 * 512 + 4 * 2816 + 4 * 1408;
        for (int it = F.gw; it < NITEMS; it += F.NGW) {
            int r = it;
            if (r < 2048) { const int j = r / 1024; transpose_item(F.ssm_w_out + (size_t)j * 1024 * 2048, 1024, 2048, wt_ssm + (size_t)j * 2048 * 1024, 1, scr, r % 1024, plane_); continue; } r -= 2048;
            if (r < 3072) { const int j = r / 1536; transpose_item(F.conv_w_in + (size_t)j * 1024 * 3072, 1024, 3072, wt_cin + (size_t)j * 3072 * 1024, 2, scr, r % 1536, plane_); continue; } r -= 3072;
            if (r < 1024) { const int j = r / 512; transpose_item(F.conv_w_out + (size_t)j * 1024 * 1024, 1024, 1024, wt_cout + (size_t)j * 1024 * 1024, 0, scr, r % 512, plane_); continue; } r -= 1024;
            if (r < 11264) { const int j = r / 2816; transpose_item(F.w_ffn_in + (size_t)j * 1024 * 5632, 1024, 5632, wt_fin + (size_t)j * 5632 * 1024, 1, scr, r % 2816, plane_); continue; } r -= 11264;
            { const int j = r / 1408; transpose_item(F.w_ffn_out + (size_t)j * 2816 * 1024, 2816, 1024, wt_fout + (size_t)j * 1024 * 2816, 0, scr, r % 1408, plane_); }
        }
    }
    for (int it = F.vcu; it < 128; it += F.G) {
        const int jg = it, jl = jg >> 6, gl = jg & 63;
        LAS f32x2v* apw = (LAS f32x2v*)(F.lds + 131072);
        LAS f32x2v* qq = apw + 320;
        LAS float* kt = (LAS float*)(qq + 64);
        v4u* pop = (v4u*)(F.ws + WS_POP); v4u* top = (v4u*)(F.ws + WS_TOP); v4u* qop = (v4u*)(F.ws + WS_QOP);
        float2* av = (float2*)(F.ws + WS_AV); float2* ap = (float2*)(F.ws + WS_AP);
        __syncthreads();
        if (ptid_ < 64) {
            const int pp = ptid_;
            const SsmP P = ssm_param(F.a_re[jg * 64 + pp], F.a_im[jg * 64 + pp], F.log_step[jg]);
            double pr = 1.0, pi = 0.0;
#pragma unroll 1
            for (int n = 0; n < 5; ++n) { apw[n * 64 + pp] = (f32x2v){(float)pr, (float)pi}; const double nr = pr * P.abr - pi * P.abi, ni = pr * P.abi + pi * P.abr; if (n < 4) { pr = nr; pi = ni; } }
            qq[pp] = (f32x2v){(float)P.qr, (float)P.qi};
            av[jg * 64 + pp] = make_float2((float)pr, (float)pi);
#pragma unroll 1
            for (int sq = 0; sq < 6; ++sq) { const double nr = pr * pr - pi * pi, ni = 2.0 * pr * pi; pr = nr; pi = ni; }
            ap[jg * 64 + pp] = make_float2((float)pr, (float)pi);
        }
        __syncthreads();
        for (int idx = ptid_; idx < 1024; idx += 512) {
            const int tau = idx >> 8, h = (idx >> 4) & 15, hp = idx & 15;
            float acc = 0.f;
            for (int pp = 0; pp < 64; ++pp) {
                const f32x2v a = apw[tau * 64 + pp]; const f32x2v q = qq[pp];
                const float br = F.b_re[((size_t)jg * 64 + pp) * 16 + h], bi = F.b_im[((size_t)jg * 64 + pp) * 16 + h];
                const float bbr = q.x * br - q.y * bi, bbi = q.x * bi + q.y * br;
                const float wr = a.x * bbr - a.y * bbi, wi = a.x * bbi + a.y * bbr;
                acc += F.c_re[((size_t)jg * 16 + hp) * 64 + pp] * wr - F.c_im[((size_t)jg * 16 + hp) * 64 + pp] * wi;
            }
            kt[idx] = acc;
        }
        __syncthreads();
        for (int pr_ = ptid_; pr_ < 1024; pr_ += 512) {
            const int f = pr_ >> 6, l = pr_ & 63, sI = f >> 2, cb = f & 3, jj = l & 31, kh = l >> 5, pp = jj + 32 * (cb & 1);
            const f32x2v a = apw[(3 - sI) * 64 + pp]; const f32x2v q = qq[pp];
            float v[8];
#pragma unroll
            for (int e = 0; e < 8; ++e) {
                const float br = F.b_re[((size_t)jg * 64 + pp) * 16 + 8 * kh + e], bi = F.b_im[((size_t)jg * 64 + pp) * 16 + 8 * kh + e];
                const float bbr = q.x * br - q.y * bi, bbi = q.x * bi + q.y * br;
                v[e] = (cb < 2) ? (a.x * bbr - a.y * bbi) : (a.x * bbi + a.y * bbr);
            }
            v4u o; o.x = pk2(v[0], v[1]); o.y = pk2(v[2], v[3]); o.z = pk2(v[4], v[5]); o.w = pk2(v[6], v[7]);
            pop[((size_t)jg * 16 + f) * 64 + l] = o;
        }
        {
            const int f = ptid_ >> 6, l = ptid_ & 63, ob = f >> 2, sI = f & 3, i = l & 31, kh = l >> 5, ig = 32 * ob + i, t = ig >> 4, hp = ig & 15;
            float v[8];
#pragma unroll
            for (int e = 0; e < 8; ++e) {
                const int h = 8 * kh + e;
                float x = (sI <= t) ? kt[(t - sI) * 256 + h * 16 + hp] : 0.f;
                if (sI == t && h == hp) x += F.ssm_d[jl * 1024 + gl * 16 + hp];
                v[e] = x;
            }
            v4u o; o.x = pk2(v[0], v[1]); o.y = pk2(v[2], v[3]); o.z = pk2(v[4], v[5]); o.w = pk2(v[6], v[7]);
            top[((size_t)jg * 8 + f) * 64 + l] = o;
        }
        for (int pr_ = ptid_; pr_ < 1024; pr_ += 512) {
            const int f = pr_ >> 6, l = pr_ & 63, ob = f >> 3, ks = f & 7, i = l & 31, kh = l >> 5, ig = 32 * ob + i, t = ig >> 4, hp = ig & 15;
            float v[8];
#pragma unroll
            for (int e = 0; e < 8; ++e) {
                const int k = 16 * ks + 8 * kh + e, j2 = k >> 2, cc = k & 3, pp = j2 + 32 * (cc & 1);
                const f32x2v a = apw[(t + 1) * 64 + pp];
                const float cr = F.c_re[((size_t)jg * 16 + hp) * 64 + pp], ci = F.c_im[((size_t)jg * 16 + hp) * 64 + pp];
                v[e] = (cc < 2) ? (cr * a.x - ci * a.y) : -(cr * a.y + ci * a.x);
            }
            v4u o; o.x = pk2(v[0], v[1]); o.y = pk2(v[2], v[3]); o.z = pk2(v[4], v[5]); o.w = pk2(v[6], v[7]);
            qop[((size_t)jg * 16 + f) * 64 + l] = o;
        }
    }
}

__device__ __forceinline__ void p0b(Ctx& F) {
    int ptid_ = threadIdx.x; asm volatile("" : "+v"(ptid_)); const int plane_ = ptid_ & 63;
    const float* mods = (const float*)(F.ws + WS_MODS);
    float* slots = (float*)(F.ws + WS_SLOTS); bf16* xs = (bf16*)(F.ws + WS_XS);
    for (int row = F.gw; row < MT; row += F.NGW) {
        const int b = row >> 12;
        const f32x4* xr = (const f32x4*)(F.x + (size_t)row * Dm) + plane_;
        f32x4 v[4]; float s = 0.f;
#pragma unroll
        for (int q = 0; q < 4; ++q) { v[q] = xr[64 * q]; s += (v[q][0] * v[q][0] + v[q][1] * v[q][1]) + (v[q][2] * v[q][2] + v[q][3] * v[q][3]); }
        s = wave_sum(s);
        if (plane_ < 16) slots[(size_t)row * 32 + plane_] = (plane_ == 0) ? s : 0.f;
#pragma unroll
        for (int q = 0; q < 4; ++q) {
            const int col = 4 * (64 * q + plane_);
            const f32x4 gs = *(const f32x4*)(F.norm1_g + col) * (*(const f32x4*)(mods + (size_t)b * 6144 + 1024 + col) + 1.f);
            const f32x4 o = v[q] * gs;
            v2u w; w.x = pk2(o[0], o[1]); w.y = pk2(o[2], o[3]);
            *(v2u*)(xs + (size_t)row * Dm + col) = w;
        }
    }
    LAS float* shl = (LAS float*)F.lds;
    {
        const int per = (28672 + F.G - 1) / F.G, r_lo = F.vcu * per, r_hi = (r_lo + per < 28672) ? r_lo + per : 28672;
        for (int mi = 0; mi < 6; ++mi) {
            const int m_lo = mi < 4 ? mi * 5632 : 22528 + (mi - 4) * 3072, N = mi < 4 ? 5632 : 3072, m_hi = m_lo + N;
            const int a = r_lo > m_lo ? r_lo : m_lo, b = r_hi < m_hi ? r_hi : m_hi;
            if (a >= b) continue;
            const int layer = mi < 4 ? mi : 2 * (mi - 4) + 1, shoff = mi < 4 ? 3072 : 0;
            const bf16* Wt = mi < 4 ? (const bf16*)(F.ws + WS_WT_FIN) + (size_t)mi * 5632 * 1024 : (const bf16*)(F.ws + WS_WT_CIN) + (size_t)(mi - 4) * 3072 * 1024;
            float* outb = mi < 4 ? (float*)(F.ws + WS_BIAS_F1) + (size_t)mi * 8 * 5632 : (float*)(F.ws + WS_BIAS_C1) + (size_t)(mi - 4) * 8 * 3072;
            __syncthreads();
            for (int idx = ptid_; idx < 8192; idx += 512) shl[idx] = mods[((size_t)layer * 8 + (idx >> 10)) * 6144 + shoff + (idx & 1023)];
            __syncthreads();
            for (int n0 = a - m_lo + F.wave; n0 < b - m_lo; n0 += 4 * NWAVES) {
                v4u wv[4][2];
#pragma unroll
                for (int r = 0; r < 4; ++r) { const int n = n0 + r * NWAVES; const int nn = n < b - m_lo ? n : n0;
#pragma unroll
                    for (int i = 0; i < 2; ++i) wv[r][i] = *(const v4u*)(Wt + (size_t)nn * 1024 + 8 * plane_ + 512 * i); }
#pragma unroll
                for (int r = 0; r < 4; ++r) {
                    const int n = n0 + r * NWAVES;
                    float acc[8];
#pragma unroll
                    for (int bb = 0; bb < 8; ++bb) acc[bb] = 0.f;
#pragma unroll
                    for (int i = 0; i < 2; ++i) {
                        const int k0 = 8 * plane_ + 512 * i;
                        const v4u w = wv[r][i];
                        const float wf[8] = {bf_lo(w.x), bf_hi(w.x), bf_lo(w.y), bf_hi(w.y), bf_lo(w.z), bf_hi(w.z), bf_lo(w.w), bf_hi(w.w)};
#pragma unroll
                        for (int bb = 0; bb < 8; ++bb) {
                            const f32x4 s0 = *(const LAS f32x4*)(shl + bb * 1024 + k0), s1 = *(const LAS f32x4*)(shl + bb * 1024 + k0 + 4);
                            acc[bb] += (wf[0] * s0[0] + wf[1] * s0[1]) + (wf[2] * s0[2] + wf[3] * s0[3]) + (wf[4] * s1[0] + wf[5] * s1[1]) + (wf[6] * s1[2] + wf[7] * s1[3]);
                        }
                    }
#pragma unroll
                    for (int bb = 0; bb < 8; ++bb) acc[bb] = wave_sum(acc[bb]);
                    if (plane_ == 0 && n < b - m_lo) {
#pragma unroll
                        for (int bb = 0; bb < 8; ++bb) outb[(size_t)bb * N + n] = acc[bb];
                    }
                }
            }
        }
    }
    __syncthreads();
}

typedef float f32x2 __attribute__((ext_vector_type(2)));
template <bool DO_B = true, bool DO_ST = true> __device__ __forceinline__ void ssm_phase(Ctx& F, int j, const float* mods_l) {
    const bf16* xs = (const bf16*)(F.ws + WS_XS); const float* slots = (const float*)(F.ws + WS_SLOTS); bf16* yg = (bf16*)(F.ws + WS_R);
    LAS float* rl = (LAS float*)F.lds;
    LAS f32x4* el = (LAS f32x4*)(F.lds + 32768);
    LAS unsigned char* xt = F.lds + 49152 + F.wave * 8704;
    int lane_ = F.lane; asm volatile("" : "+v"(lane_));
    const int lane = lane_, jj = lane & 31, half = lane >> 5, w = F.wave;
    for (int chain = F.vcu; chain < 256; chain += F.G) {
        const int bp = chain >> 6, g = chain & 63, jg = j * 64 + g;
        int stid_ = threadIdx.x; asm volatile("" : "+v"(stid_));
        for (int r0 = stid_; r0 < 8192; r0 += 2048) {
            f32x4 v[4][4];
#pragma unroll
            for (int k = 0; k < 4; ++k)
#pragma unroll
                for (int q = 0; q < 4; ++q) v[k][q] = *((const f32x4*)(slots + ((size_t)bp * 8192 + r0 + 512 * k) * 32) + q);
#pragma unroll
            for (int k = 0; k < 4; ++k) {
                float s = 0.f;
#pragma unroll
                for (int q = 0; q < 4; ++q) s += (v[k][q][0] + v[k][q][1]) + (v[k][q][2] + v[k][q][3]);
                rl[r0 + 512 * k] = rsqrtf(s * (1.f / 1024.f) + 1e-6f);
            }
        }
        LAS float* shl = (LAS float*)(F.lds + 126976);
        if (stid_ < 32) shl[stid_] = mods_l[(size_t)(2 * bp + (stid_ >> 4)) * 6144 + g * 16 + (stid_ & 15)];
        __syncthreads();
        bf16x8 bop[4], dop;
#pragma unroll
        for (int cb = 0; cb < 4; ++cb) bop[cb] = __builtin_bit_cast(bf16x8, ((const v4u*)(F.ws + WS_BOP))[((size_t)jg * 4 + cb) * 64 + lane]);
        LAS v4u* copl = (LAS v4u*)(F.lds + 118784);
        if (w == 0) {
#pragma unroll
            for (int ks = 0; ks < 8; ++ks) copl[ks * 64 + lane] = ((const v4u*)(F.ws + WS_COP))[((size_t)jg * 8 + ks) * 64 + lane];
        }
        {
            const float dv = (jj < 16) ? F.ssm_d[j * 1024 + g * 16 + jj] : 0.f;
            const unsigned short db = (unsigned short)(pk2(dv, 0.f) & 0xffffu);
#pragma unroll
            for (int e = 0; e < 8; ++e) dop[e] = (short)((jj < 16 && jj == 8 * half + e) ? db : (unsigned short)0);
        }
        const float2 a0 = ((const float2*)(F.ws + WS_AV))[jg * 64 + jj], a1 = ((const float2*)(F.ws + WS_AV))[jg * 64 + jj + 32];
        const int rb = jj & 1, rh = (jj >> 2) & 1, rtau = ((jj >> 1) & 1) + 2 * (jj >> 3);
        const size_t rowbase = (size_t)(2 * bp + rb) * SEQ + 256 * (w + 8 * rh) + rtau;
        const bf16* up = xs + rowbase * Dm + g * 16 + 8 * half;
        const LAS float* rlp = rl + rb * SEQ + 256 * (w + 8 * rh) + rtau;
        const LAS f32x4* shp = (const LAS f32x4*)(shl + (rb * 2 + half) * 8);
        f32x16 zero16;
#pragma unroll
        for (int i = 0; i < 16; ++i) zero16[i] = 0.f;
        f32x2 pr0 = {0.f, 0.f}, pi0 = {0.f, 0.f}, pr1 = {0.f, 0.f}, pi1 = {0.f, 0.f};
#define SSM_UOP(raw, t0, uop) do { const float rs_ = rlp[(t0)]; v4u p_; const f32x4 s0_ = shp[0], s1_ = shp[1]; const float sh[8] = {s0_[0], s0_[1], s0_[2], s0_[3], s1_[0], s1_[1], s1_[2], s1_[3]}; \
            p_.x = pk2(bf_lo((raw).x) * rs_ + sh[0], bf_hi((raw).x) * rs_ + sh[1]); p_.y = pk2(bf_lo((raw).y) * rs_ + sh[2], bf_hi((raw).y) * rs_ + sh[3]); \
            p_.z = pk2(bf_lo((raw).z) * rs_ + sh[4], bf_hi((raw).z) * rs_ + sh[5]); p_.w = pk2(bf_lo((raw).w) * rs_ + sh[6], bf_hi((raw).w) * rs_ + sh[7]); \
            uop = __builtin_bit_cast(bf16x8, p_); } while (0)
#define SSM_STEP(tau) do { const f32x2 dr0 = {d0[2 * (tau)], d0[2 * (tau) + 1]}, di0 = {d2[2 * (tau)], d2[2 * (tau) + 1]}, dr1 = {d1[2 * (tau)], d1[2 * (tau) + 1]}, di1 = {d3[2 * (tau)], d3[2 * (tau) + 1]}; \
            const f32x2 nr0 = pr0 * a0.x - pi0 * a0.y + dr0, ni0 = pi0 * a0.x + pr0 * a0.y + di0, nr1 = pr1 * a1.x - pi1 * a1.y + dr1, ni1 = pi1 * a1.x + pr1 * a1.y + di1; \
            pr0 = nr0; pi0 = ni0; pr1 = nr1; pi1 = ni1; } while (0)
        {
            v4u r0 = *(const v4u*)(up), r1 = *(const v4u*)(up + (size_t)8 * Dm), r2 = *(const v4u*)(up + (size_t)16 * Dm), r3 = *(const v4u*)(up + (size_t)24 * Dm),
                r4 = *(const v4u*)(up + (size_t)32 * Dm), r5 = *(const v4u*)(up + (size_t)40 * Dm);
            for (int tile = 0; tile < 32; ++tile) {
                const int t0 = 8 * tile;
                const v4u cur = r0;
                r0 = r1; r1 = r2; r2 = r3; r3 = r4; r4 = r5;
                if (tile < 26) r5 = *(const v4u*)(up + (size_t)(t0 + 48) * Dm);
                bf16x8 uop; SSM_UOP(cur, t0, uop);
                const f32x16 d0 = MFMA32(uop, bop[0], zero16), d1 = MFMA32(uop, bop[1], zero16), d2 = MFMA32(uop, bop[2], zero16), d3 = MFMA32(uop, bop[3], zero16);
#pragma unroll
                for (int tau = 0; tau < 8; ++tau) SSM_STEP(tau);
            }
        }
        {
            const int mych = w + 8 * half;
            el[(mych * 32 + jj) * 2] = (f32x4){pr0.x, pr0.y, pi0.x, pi0.y};
            el[(mych * 32 + jj) * 2 + 1] = (f32x4){pr1.x, pr1.y, pi1.x, pi1.y};
            __syncthreads();
            const float2 p0 = ((const float2*)(F.ws + WS_AP))[jg * 64 + jj], p1 = ((const float2*)(F.ws + WS_AP))[jg * 64 + jj + 32];
            pr0 = (f32x2){0.f, 0.f}; pi0 = pr0; pr1 = pr0; pi1 = pr0;
            for (int c = 0; c < mych; ++c) {
                const f32x4 e0 = el[(c * 32 + jj) * 2], e1 = el[(c * 32 + jj) * 2 + 1];
                const f32x2 nr0 = pr0 * p0.x - pi0 * p0.y + (f32x2){e0[0], e0[1]}, ni0 = pi0 * p0.x + pr0 * p0.y + (f32x2){e0[2], e0[3]};
                const f32x2 nr1 = pr1 * p1.x - pi1 * p1.y + (f32x2){e1[0], e1[1]}, ni1 = pi1 * p1.x + pr1 * p1.y + (f32x2){e1[2], e1[3]};
                pr0 = nr0; pi0 = ni0; pr1 = nr1; pi1 = ni1;
            }
        }
        if (DO_B) {
            bf16* yp = yg + rowbase * Dm + g * 16 + 4 * half;
#define SSM_SCAN_WRITE() do { _Pragma("unroll") for (int tau = 0; tau < 8; ++tau) { SSM_STEP(tau); \
                    v2u w0, w1; w0.x = pk2(pr0.x, pr1.x); w0.y = pk2(pi0.x, pi1.x); w1.x = pk2(pr0.y, pr1.y); w1.y = pk2(pi0.y, pi1.y); \
                    *(LAS v2u*)(xt + (((2 * tau) & 3) + 8 * ((2 * tau) >> 2) + 4 * half) * 272 + 8 * jj) = w0; \
                    *(LAS v2u*)(xt + (((2 * tau + 1) & 3) + 8 * ((2 * tau + 1) >> 2) + 4 * half) * 272 + 8 * jj) = w1; } } while (0)
#define SSM_CPROD(y, uprev) do { y = zero16; _Pragma("unroll") for (int ks = 0; ks < 8; ++ks) { const bf16x8 xop = *(const LAS bf16x8*)(xt + jj * 272 + 32 * ks + 16 * half); y = MFMA32(__builtin_bit_cast(bf16x8, copl[ks * 64 + lane]), xop, y); } \
                    y = MFMA32(dop, uprev, y); } while (0)
#define SSM_OUT(y, tp) do { v2u o0, o1; o0.x = pk2(gelu_tanh(y[0]), gelu_tanh(y[1])); o0.y = pk2(gelu_tanh(y[2]), gelu_tanh(y[3])); \
                    o1.x = pk2(gelu_tanh(y[4]), gelu_tanh(y[5])); o1.y = pk2(gelu_tanh(y[6]), gelu_tanh(y[7])); \
                    if (DO_ST || (o0.x ^ o1.y) == 0x12345679u) { *(v2u*)(yp + (size_t)(tp) * Dm) = o0; *(v2u*)(yp + (size_t)(tp) * Dm + 8) = o1; } } while (0)
            v4u r0 = *(const v4u*)(up);
            bf16x8 uprev;
            {
                const v4u cur = r0; r0 = *(const v4u*)(up + (size_t)8 * Dm);
                bf16x8 uop; SSM_UOP(cur, 0, uop);
                const f32x16 d0 = MFMA32(uop, bop[0], zero16), d1 = MFMA32(uop, bop[1], zero16), d2 = MFMA32(uop, bop[2], zero16), d3 = MFMA32(uop, bop[3], zero16);
                SSM_SCAN_WRITE();
                uprev = uop;
            }
            for (int tile = 1; tile < 32; ++tile) {
                const int t0 = 8 * tile;
                const v4u cur = r0;
                if (tile < 31) r0 = *(const v4u*)(up + (size_t)(t0 + 8) * Dm);
                bf16x8 uop; SSM_UOP(cur, t0, uop);
                const f32x16 d0 = MFMA32(uop, bop[0], zero16), d1 = MFMA32(uop, bop[1], zero16), d2 = MFMA32(uop, bop[2], zero16), d3 = MFMA32(uop, bop[3], zero16);
                WAVE_LDS_SYNC();
                f32x16 y; SSM_CPROD(y, uprev);
                WAVE_LDS_SYNC();
                SSM_SCAN_WRITE();
                SSM_OUT(y, t0 - 8);
                uprev = uop;
            }
            {
                WAVE_LDS_SYNC();
                f32x16 y; SSM_CPROD(y, uprev);
                SSM_OUT(y, 248);
            }
#undef SSM_SCAN_WRITE
#undef SSM_CPROD
#undef SSM_OUT
        }
#undef SSM_UOP
#undef SSM_STEP
        if (!DO_B && pr0.x + pi0.x + pr1.y + pi1.y == 1.2345e30f) rl[0] = 1.f;
        __syncthreads();
    }
}

__device__ __forceinline__ void ssm_phase2(Ctx& F, int j, const float* mods_l) {
    const bf16* xs = (const bf16*)(F.ws + WS_XS); const float* slots = (const float*)(F.ws + WS_SLOTS); bf16* yg = (bf16*)(F.ws + WS_R);
    LAS float* rl = (LAS float*)F.lds;
    LAS v4u* popl = (LAS v4u*)(F.lds + 32768);
    LAS v4u* topl = (LAS v4u*)(F.lds + 49152);
    LAS v4u* qopl = (LAS v4u*)(F.lds + 57344);
    LAS unsigned char* xt = F.lds + 73728 + F.wave * 8704;
    LAS f32x4* el = (LAS f32x4*)(F.lds + 73728);
    LAS float* shl = (LAS float*)(F.lds + 73728 + 8 * 8704);
    int lane_ = threadIdx.x & 63; asm volatile("" : "+v"(lane_));
    const int lane = lane_, jj = lane & 31, half = lane >> 5, w = F.wave;
    for (int chain = F.vcu; chain < 256; chain += F.G) {
        const int bp = chain >> 6, g = chain & 63, jg = j * 64 + g;
        int stid_ = threadIdx.x; asm volatile("" : "+v"(stid_));
        for (int r0 = stid_; r0 < 8192; r0 += 2048) {
            f32x4 v[4][4];
#pragma unroll
            for (int k = 0; k < 4; ++k)
#pragma unroll
                for (int q = 0; q < 4; ++q) v[k][q] = *((const f32x4*)(slots + ((size_t)bp * 8192 + r0 + 512 * k) * 32) + q);
#pragma unroll
            for (int k = 0; k < 4; ++k) {
                float sm = 0.f;
#pragma unroll
                for (int q = 0; q < 4; ++q) sm += (v[k][q][0] + v[k][q][1]) + (v[k][q][2] + v[k][q][3]);
                rl[r0 + 512 * k] = rsqrtf(sm * (1.f / 1024.f) + 1e-6f);
            }
        }
        if (stid_ < 32) shl[stid_] = mods_l[(size_t)(2 * bp + (stid_ >> 4)) * 6144 + g * 16 + (stid_ & 15)];
        {
            v4u o[5];
#pragma unroll
            for (int k = 0; k < 5; ++k) {
                const int idx = stid_ + 512 * k;
                if (idx < 1024) o[k] = ((const v4u*)(F.ws + WS_POP))[(size_t)jg * 1024 + idx];
                else if (idx < 1536) o[k] = ((const v4u*)(F.ws + WS_TOP))[(size_t)jg * 512 + idx - 1024];
                else o[k] = ((const v4u*)(F.ws + WS_QOP))[(size_t)jg * 1024 + idx - 1536];
            }
#pragma unroll
            for (int k = 0; k < 5; ++k) popl[stid_ + 512 * k] = o[k];
        }
        __syncthreads();
        const float2 a0 = ((const float2*)(F.ws + WS_AV))[jg * 64 + jj], a1 = ((const float2*)(F.ws + WS_AV))[jg * 64 + jj + 32];
        const f32x2 ax0 = {a0.x, a0.x}, ay0 = {a0.y, a0.y}, ax1 = {a1.x, a1.x}, ay1 = {a1.y, a1.y};
        const int rb = jj & 1, rh = (jj >> 2) & 1, rk = ((jj >> 1) & 1) + 2 * (jj >> 3);
        const size_t rowbase = (size_t)(2 * bp + rb) * SEQ + 256 * (w + 8 * rh) + 4 * rk;
        const bf16* up = xs + rowbase * Dm + g * 16 + 8 * half;
        const LAS float* rlp = rl + rb * SEQ + 256 * (w + 8 * rh) + 4 * rk;
        const LAS f32x4* shp = (const LAS f32x4*)(shl + (rb * 2 + half) * 8);
        f32x16 zero16;
#pragma unroll
        for (int i = 0; i < 16; ++i) zero16[i] = 0.f;
        f32x2 pr0 = {0.f, 0.f}, pi0 = {0.f, 0.f}, pr1 = {0.f, 0.f}, pi1 = {0.f, 0.f};
#define S2_UOP(raw, toff, uop) do { const float rs_ = rlp[(toff)]; const f32x4 s0_ = shp[0], s1_ = shp[1]; v4u p_; \
            p_.x = pk2(bf_lo((raw).x) * rs_ + s0_[0], bf_hi((raw).x) * rs_ + s0_[1]); p_.y = pk2(bf_lo((raw).y) * rs_ + s0_[2], bf_hi((raw).y) * rs_ + s0_[3]); \
            p_.z = pk2(bf_lo((raw).z) * rs_ + s1_[0], bf_hi((raw).z) * rs_ + s1_[1]); p_.w = pk2(bf_lo((raw).w) * rs_ + s1_[2], bf_hi((raw).w) * rs_ + s1_[3]); \
            uop = __builtin_bit_cast(bf16x8, p_); } while (0)
#define S2_ESTEP(k) do { const f32x2 dr0 = {d0[2 * (k)], d0[2 * (k) + 1]}, di0 = {d2[2 * (k)], d2[2 * (k) + 1]}, dr1 = {d1[2 * (k)], d1[2 * (k) + 1]}, di1 = {d3[2 * (k)], d3[2 * (k) + 1]}; \
            const f32x2 nr0 = __builtin_elementwise_fma(-pi0, ay0, __builtin_elementwise_fma(pr0, ax0, dr0)), ni0 = __builtin_elementwise_fma(pr0, ay0, __builtin_elementwise_fma(pi0, ax0, di0)); \
            const f32x2 nr1 = __builtin_elementwise_fma(-pi1, ay1, __builtin_elementwise_fma(pr1, ax1, dr1)), ni1 = __builtin_elementwise_fma(pr1, ay1, __builtin_elementwise_fma(pi1, ax1, di1)); \
            pr0 = nr0; pi0 = ni0; pr1 = nr1; pi1 = ni1; } while (0)
#define S2_EPROD() f32x16 d0 = zero16, d1 = zero16, d2 = zero16, d3 = zero16; _Pragma("unroll") for (int sI = 0; sI < 4; ++sI) { \
            d0 = MFMA32(u[sI], __builtin_bit_cast(bf16x8, popl[(sI * 4 + 0) * 64 + lane]), d0); d1 = MFMA32(u[sI], __builtin_bit_cast(bf16x8, popl[(sI * 4 + 1) * 64 + lane]), d1); \
            d2 = MFMA32(u[sI], __builtin_bit_cast(bf16x8, popl[(sI * 4 + 2) * 64 + lane]), d2); d3 = MFMA32(u[sI], __builtin_bit_cast(bf16x8, popl[(sI * 4 + 3) * 64 + lane]), d3); }
        {
            v4u raw[4];
#pragma unroll
            for (int sI = 0; sI < 4; ++sI) raw[sI] = *(const v4u*)(up + (size_t)sI * Dm);
            for (int rbk = 0; rbk < 8; ++rbk) {
                bf16x8 u[4];
#pragma unroll
                for (int sI = 0; sI < 4; ++sI) { S2_UOP(raw[sI], 32 * rbk + sI, u[sI]); if (rbk < 7) raw[sI] = *(const v4u*)(up + (size_t)(32 * (rbk + 1) + sI) * Dm); }
                S2_EPROD();
#pragma unroll
                for (int k = 0; k < 8; ++k) S2_ESTEP(k);
            }
        }
        {
            const int mych = w + 8 * half;
            __syncthreads();
            el[(mych * 32 + jj) * 2] = (f32x4){pr0.x, pr0.y, pi0.x, pi0.y};
            el[(mych * 32 + jj) * 2 + 1] = (f32x4){pr1.x, pr1.y, pi1.x, pi1.y};
            __syncthreads();
            const float2 p0 = ((const float2*)(F.ws + WS_AP))[jg * 64 + jj], p1 = ((const float2*)(F.ws + WS_AP))[jg * 64 + jj + 32];
            pr0 = (f32x2){0.f, 0.f}; pi0 = pr0; pr1 = pr0; pi1 = pr0;
            for (int c = 0; c < mych; ++c) {
                const f32x4 e0 = el[(c * 32 + jj) * 2], e1 = el[(c * 32 + jj) * 2 + 1];
                const f32x2 nr0 = pr0 * p0.x - pi0 * p0.y + (f32x2){e0[0], e0[1]}, ni0 = pi0 * p0.x + pr0 * p0.y + (f32x2){e0[2], e0[3]};
                const f32x2 nr1 = pr1 * p1.x - pi1 * p1.y + (f32x2){e1[0], e1[1]}, ni1 = pi1 * p1.x + pr1 * p1.y + (f32x2){e1[2], e1[3]};
                pr0 = nr0; pi0 = ni0; pr1 = nr1; pi1 = ni1;
            }
            __syncthreads();
        }
        {
            bf16* yp = yg + rowbase * Dm + g * 16 + 4 * half;
            v4u raw[4];
#pragma unroll
            for (int sI = 0; sI < 4; ++sI) raw[sI] = *(const v4u*)(up + (size_t)sI * Dm);
            for (int rbk = 0; rbk < 8; ++rbk) {
                bf16x8 u[4];
#pragma unroll
                for (int sI = 0; sI < 4; ++sI) { S2_UOP(raw[sI], 32 * rbk + sI, u[sI]); if (rbk < 7) raw[sI] = *(const v4u*)(up + (size_t)(32 * (rbk + 1) + sI) * Dm); }
                S2_EPROD();
#pragma unroll
                for (int k = 0; k < 8; ++k) {
                    v2u w0, w1; w0.x = pk2(pr0.x, pr1.x); w0.y = pk2(pi0.x, pi1.x); w1.x = pk2(pr0.y, pr1.y); w1.y = pk2(pi0.y, pi1.y);
                    *(LAS v2u*)(xt + (((2 * k) & 3) + 8 * ((2 * k) >> 2) + 4 * half) * 272 + 8 * jj) = w0;
                    *(LAS v2u*)(xt + (((2 * k + 1) & 3) + 8 * ((2 * k + 1) >> 2) + 4 * half) * 272 + 8 * jj) = w1;
                    S2_ESTEP(k);
                }
                WAVE_LDS_SYNC();
#pragma unroll
                for (int ob = 0; ob < 2; ++ob) {
                    f32x16 y = zero16;
#pragma unroll
                    for (int sI = 0; sI < 4; ++sI) y = MFMA32(__builtin_bit_cast(bf16x8, topl[(ob * 4 + sI) * 64 + lane]), u[sI], y);
#pragma unroll
                    for (int ks = 0; ks < 8; ++ks) {
                        const bf16x8 xop = *(const LAS bf16x8*)(xt + jj * 272 + 32 * ks + 16 * half);
                        y = MFMA32(__builtin_bit_cast(bf16x8, qopl[(ob * 8 + ks) * 64 + lane]), xop, y);
                    }
#pragma unroll
                    for (int tl = 0; tl < 2; ++tl) {
                        v2u o0, o1;
                        o0.x = pk2(gelu_fast(y[8 * tl + 0]), gelu_fast(y[8 * tl + 1])); o0.y = pk2(gelu_fast(y[8 * tl + 2]), gelu_fast(y[8 * tl + 3]));
                        o1.x = pk2(gelu_fast(y[8 * tl + 4]), gelu_fast(y[8 * tl + 5])); o1.y = pk2(gelu_fast(y[8 * tl + 6]), gelu_fast(y[8 * tl + 7]));
                        bf16* q = yp + (size_t)(32 * rbk + 2 * ob + tl) * Dm;
                        *(v2u*)(q) = o0; *(v2u*)(q + 8) = o1;
                    }
                }
                WAVE_LDS_SYNC();
            }
        }
#undef S2_UOP
#undef S2_ESTEP
#undef S2_EPROD
        __syncthreads();
    }
}

__device__ __forceinline__ void conv_phase(Ctx& F, int j) {
    bf16* bg = (bf16*)(F.ws + WS_R); const bf16* cv = (const bf16*)(F.ws + WS_R + 64 * MiB);
    int tid_ = F.tid; asm volatile("" : "+v"(tid_));
    const int co = tid_ & 127, rb = tid_ >> 7;
    float w0[8], w1[8], w2[8];
#pragma unroll
    for (int e = 0; e < 8; ++e) { w0[e] = F.conv_w[(size_t)j * 3072 + 8 * co + e]; w1[e] = F.conv_w[(size_t)j * 3072 + 1024 + 8 * co + e]; w2[e] = F.conv_w[(size_t)j * 3072 + 2048 + 8 * co + e]; }
    for (int item = blockIdx.x; item < MT / 64; item += F.G) {
        const int r0 = item * 64 + rb * 16;
        float m2[8], m1[8];
        if ((r0 & (SEQ - 1)) != 0) {
            const v4u a = *(const v4u*)(cv + (size_t)(r0 - 2) * Dm + 8 * co), b = *(const v4u*)(cv + (size_t)(r0 - 1) * Dm + 8 * co);
            m2[0] = bf_lo(a.x); m2[1] = bf_hi(a.x); m2[2] = bf_lo(a.y); m2[3] = bf_hi(a.y); m2[4] = bf_lo(a.z); m2[5] = bf_hi(a.z); m2[6] = bf_lo(a.w); m2[7] = bf_hi(a.w);
            m1[0] = bf_lo(b.x); m1[1] = bf_hi(b.x); m1[2] = bf_lo(b.y); m1[3] = bf_hi(b.y); m1[4] = bf_lo(b.z); m1[5] = bf_hi(b.z); m1[6] = bf_lo(b.w); m1[7] = bf_hi(b.w);
        } else {
#pragma unroll
            for (int e = 0; e < 8; ++e) { m2[e] = 0.f; m1[e] = 0.f; }
        }
#pragma unroll 4
        for (int r = 0; r < 16; ++r) {
            const size_t o = (size_t)(r0 + r) * Dm + 8 * co;
            const v4u cc = *(const v4u*)(cv + o), bb = *(const v4u*)(bg + o);
            const float c0[8] = {bf_lo(cc.x), bf_hi(cc.x), bf_lo(cc.y), bf_hi(cc.y), bf_lo(cc.z), bf_hi(cc.z), bf_lo(cc.w), bf_hi(cc.w)};
            const float bv[8] = {bf_lo(bb.x), bf_hi(bb.x), bf_lo(bb.y), bf_hi(bb.y), bf_lo(bb.z), bf_hi(bb.z), bf_lo(bb.w), bf_hi(bb.w)};
            float p[8];
#pragma unroll
            for (int e = 0; e < 8; ++e) { p[e] = bv[e] * (w0[e] * m2[e] + w1[e] * m1[e] + w2[e] * c0[e]); m2[e] = m1[e]; m1[e] = c0[e]; }
            v4u w; w.x = pk2(p[0], p[1]); w.y = pk2(p[2], p[3]); w.z = pk2(p[4], p[5]); w.w = pk2(p[6], p[7]);
            *(v4u*)(bg + o) = w;
        }
    }
}

__device__ __forceinline__ void final_phase(Ctx& F) {
    const float* slots = (const float*)(F.ws + WS_SLOTS);
    int ft_ = threadIdx.x; asm volatile("" : "+v"(ft_)); const int fl_ = ft_ & 63, fgw_ = F.vcu * NWAVES + __builtin_amdgcn_readfirstlane(ft_ >> 6);
    f32x4 g[4];
#pragma unroll
    for (int q = 0; q < 4; ++q) g[q] = *((const f32x4*)F.final_g + 64 * q + fl_);
    for (int row = fgw_; row < MT; row += 2 * F.NGW) {
        const int row2 = row + F.NGW; const bool has2 = row2 < MT;
        f32x4* xa = (f32x4*)(F.out + (size_t)row * Dm) + fl_;
        f32x4* xb2 = (f32x4*)(F.out + (size_t)(has2 ? row2 : row) * Dm) + fl_;
        f32x4 va[4], vb[4];
#pragma unroll
        for (int q = 0; q < 4; ++q) { va[q] = xa[64 * q]; vb[q] = xb2[64 * q]; }
        float sa = 0.f, sb = 0.f;
        if (fl_ < 16) { sa = slots[(size_t)row * 32 + fl_]; sb = slots[(size_t)(has2 ? row2 : row) * 32 + fl_]; }
        sa = wave_sum(sa); sb = wave_sum(sb);
        const float ra = rsqrtf(sa * (1.f / 1024.f) + 1e-6f), rb = rsqrtf(sb * (1.f / 1024.f) + 1e-6f);
#pragma unroll
        for (int q = 0; q < 4; ++q) __builtin_nontemporal_store(va[q] * ra * g[q], xa + 64 * q);
        if (has2) {
#pragma unroll
            for (int q = 0; q < 4; ++q) __builtin_nontemporal_store(vb[q] * rb * g[q], xb2 + 64 * q);
        }
    }
}

#ifndef PH_LO
#define PH_LO 0
#endif
#ifndef PH_HI
#define PH_HI 99
#endif
__global__ void __launch_bounds__(NWAVES * 64, 2) fwd_megakernel(Args args) {
    extern __shared__ __attribute__((aligned(16))) unsigned char lds_raw[];
    cg::grid_group grid = cg::this_grid();
#define GRID_SYNC() xcd_barrier(bar)
    Ctx F;
    F.lds = (LAS unsigned char*)lds_raw;
    F.tid = threadIdx.x; F.lane = F.tid & 63; F.wave = __builtin_amdgcn_readfirstlane(F.tid >> 6);
    F.G = gridDim.x; { const int bx = blockIdx.x; F.vcu = (F.G % 8 == 0) ? (bx % 8) * (F.G / 8) + bx / 8 : bx; }
    F.gw = F.vcu * NWAVES + F.wave; F.NGW = F.G * NWAVES;
    F.x = args.in[0]; F.c = args.in[1]; F.norm1_g = args.in[2]; F.norm2_g = args.in[3]; F.w_ada = args.in[4]; F.b_ada = args.in[5];
    F.a_re = args.in[6]; F.a_im = args.in[7]; F.log_step = args.in[8]; F.b_re = args.in[9]; F.b_im = args.in[10]; F.c_re = args.in[11]; F.c_im = args.in[12];
    F.ssm_d = args.in[13]; F.ssm_w_out = args.in[14]; F.conv_w_in = args.in[15]; F.conv_w = args.in[16]; F.conv_w_out = args.in[17];
    F.w_ffn_in = args.in[18]; F.w_ffn_out = args.in[19]; F.final_g = args.in[20]; F.out = args.out; F.ws = args.ws;
    unsigned char* ws = args.ws;
    const float* mods = (const float*)(ws + WS_MODS);
    float* slots = (float*)(ws + WS_SLOTS); bf16* xs = (bf16*)(ws + WS_XS); bf16* xb = (bf16*)(ws + WS_XB);
    pg8::bf16_t* R = (pg8::bf16_t*)(ws + WS_R);
    PG8_LAS float* rl = (PG8_LAS float*)(F.lds + STAGE_LDS);
    PG8_LAS unsigned char* glds = (PG8_LAS unsigned char*)F.lds;

    {
        volatile LAS unsigned* misc = (volatile LAS unsigned*)(F.lds + MISC_LDS);
        if (F.tid < 4) misc[F.tid] = 0u;
        __syncthreads();
    }
    const XcdBarrier bar = xcd_barrier_post((unsigned*)(ws + WS_BAR), (volatile LAS unsigned*)(F.lds + MISC_LDS));
    if (args.out == nullptr) grid.sync();
    p0a(F);
    GRID_SYNC();
    p0b(F);
    GRID_SYNC();
#ifdef PROBE_P0
#if PROBE_P0 != 3
    p0a(F);
    GRID_SYNC();
#endif
#if PROBE_P0 != 2
    p0b(F);
    GRID_SYNC();
#endif
#endif
    for (int i = 0; i < 4; ++i) {
        const int j = i >> 1;
        const float* ml = mods + (size_t)i * 8 * 6144;
        if ((i & 1) == 0) {
            ssm_phase2(F, j, ml);
#ifdef PROBE_SSM
            GRID_SYNC(); ssm_phase2(F, j, ml);
#endif
            GRID_SYNC();
            {
                pg8::Gemm g{R, (const pg8::bf16_t*)(ws + WS_WT_SSM) + (size_t)j * 2048 * 1024, MT, 2048, 1024};
                pg8::StaticOrder S; S.init(MT, 2048, F.G, (int)blockIdx.x);
                if (i == 0) {
                    pg8::EpiGluRes<true> E{F.x, xb, xb, xs, ml + 2048, F.norm2_g + i * Dm, ml + 4096, slots};
                    pg8::gemm_phase<pg8::EpiGluRes<true>, pg8::StaticOrder, true, true>(glds, g, S, E);
                } else {
                    pg8::EpiGluRes<false> E{F.x, xb, xb, xs, ml + 2048, F.norm2_g + i * Dm, ml + 4096, slots};
                    pg8::gemm_phase<pg8::EpiGluRes<false>, pg8::StaticOrder, true, true>(glds, g, S, E);
                }
            }
            GRID_SYNC();
        } else {
            {
                pg8::Gemm g{xs, (const pg8::bf16_t*)(ws + WS_WT_CIN) + (size_t)j * 3072 * 1024, MT, 2048, 1024};
                pg8::StaticOrder S; S.init(MT, 2048, F.G, (int)blockIdx.x);
                pg8::phase_rstd<16>(rl, slots, S);
                pg8::EpiCV E{R + (size_t)MT * Dm, (const float*)(ws + WS_BIAS_C1) + (size_t)j * 8 * 3072, rl};
                pg8::gemm_phase<pg8::EpiCV, pg8::StaticOrder, true, true>(glds, g, S, E);
            }
            GRID_SYNC();
            {
                pg8::Gemm g{xs, (const pg8::bf16_t*)(ws + WS_WT_CIN) + (size_t)j * 3072 * 1024 + (size_t)2048 * 1024, MT, 1024, 1024};
                pg8::StaticOrder S; S.init(MT, 1024, F.G, (int)blockIdx.x);
                pg8::phase_rstd<16>(rl, slots, S);
                pg8::EpiBGP E{R + (size_t)MT * Dm, R, (const float*)(ws + WS_BIAS_C1) + (size_t)j * 8 * 3072, F.conv_w + (size_t)j * 3072, rl};
                pg8::gemm_phase<pg8::EpiBGP, pg8::StaticOrder, true, true>(glds, g, S, E);
            }
            GRID_SYNC();
            {
                pg8::Gemm g{R, (const pg8::bf16_t*)(ws + WS_WT_COUT) + (size_t)j * 1024 * 1024, MT, 1024, 1024};
                pg8::StaticOrder S; S.init(MT, 1024, F.G, (int)blockIdx.x);
                pg8::EpiRes<false> E{xb, xb, F.out, xs, ml + 2048, F.norm2_g + i * Dm, ml + 4096, slots};
                pg8::gemm_phase<pg8::EpiRes<false>, pg8::StaticOrder, true, true>(glds, g, S, E);
            }
            GRID_SYNC();
        }
        {
            pg8::Gemm g{xs, (const pg8::bf16_t*)(ws + WS_WT_FIN) + (size_t)i * 5632 * 1024, MT, 5632, 1024};
            pg8::StaticOrder S; S.init(MT, 5632, F.G, (int)blockIdx.x);
            if (i & 1) {
                pg8::phase_rstd<16>(rl, slots, S);
                pg8::EpiF1<16> E{R, (const float*)(ws + WS_BIAS_F1) + (size_t)i * 8 * 5632, slots, rl};
                pg8::gemm_phase<pg8::EpiF1<16>, pg8::StaticOrder, true, true>(glds, g, S, E);
            } else {
                pg8::phase_rstd<32>(rl, slots, S);
                pg8::EpiF1<32> E{R, (const float*)(ws + WS_BIAS_F1) + (size_t)i * 8 * 5632, slots, rl};
                pg8::gemm_phase<pg8::EpiF1<32>, pg8::StaticOrder, true, true>(glds, g, S, E);
            }
        }
        GRID_SYNC();
#ifdef PROBE_F1DUP
        {
            pg8::Gemm g{xs, (const pg8::bf16_t*)(ws + WS_WT_FIN) + (size_t)i * 5632 * 1024, MT, 5632, 1024};
            pg8::StaticOrder S; S.init(MT, 5632, F.G, (int)blockIdx.x);
            if (i & 1) pg8::phase_rstd<16>(rl, slots, S); else pg8::phase_rstd<32>(rl, slots, S);
            pg8::EpiF1<32> E{R, (const float*)(ws + WS_BIAS_F1) + (size_t)i * 8 * 5632, slots, rl};
            pg8::gemm_phase<pg8::EpiF1<32>, pg8::StaticOrder, true, true>(glds, g, S, E);
        }
        GRID_SYNC();
#endif
#ifdef PROBE_F1NULL
        {
            pg8::Gemm g{xs, (const pg8::bf16_t*)(ws + WS_WT_FIN) + (size_t)i * 5632 * 1024, MT, 5632, 1024};
            pg8::StaticOrder S; S.init(MT, 5632, F.G, (int)blockIdx.x);
            pg8::EpiNull E{slots};
            pg8::gemm_phase<pg8::EpiNull, pg8::StaticOrder, true, true>(glds, g, S, E);
        }
        GRID_SYNC();
#endif
#ifdef PROBE_F2NULL
        {
            pg8::Gemm g{R, (const pg8::bf16_t*)(ws + WS_WT_FOUT) + (size_t)i * 1024 * 2816, MT, 1024, 2816};
            pg8::StaticOrder S; S.init(MT, 1024, F.G, (int)blockIdx.x);
            pg8::EpiNull E{slots};
            pg8::gemm_phase<pg8::EpiNull, pg8::StaticOrder, true, true>(glds, g, S, E);
        }
        GRID_SYNC();
#endif
        {
            pg8::Gemm g{R, (const pg8::bf16_t*)(ws + WS_WT_FOUT) + (size_t)i * 1024 * 2816, MT, 1024, 2816};
            pg8::StaticOrder S; S.init(MT, 1024, F.G, (int)blockIdx.x);
            const float* mn = mods + (size_t)(i + 1) * 8 * 6144;
            if (i < 3) {
                pg8::EpiRes<false> E{xb, xb, F.out, xs, ml + 5120, F.norm1_g + (i + 1) * Dm, mn + 1024, slots};
                pg8::gemm_phase<pg8::EpiRes<false>, pg8::StaticOrder, true, true>(glds, g, S, E);
            } else {
                pg8::EpiRes<true> E{xb, xb, F.out, xs, ml + 5120, F.norm1_g, ml, slots};
                pg8::gemm_phase<pg8::EpiRes<true>, pg8::StaticOrder, true, true>(glds, g, S, E);
            }
        }
        GRID_SYNC();
    }
    final_phase(F);
}

extern "C" void kernel_launch(void* const* d_in, const int* in_sizes, int n_in, void* d_out, int out_size, void* d_ws, size_t ws_size, hipStream_t stream) {
    static int grid = 0;
    if (grid == 0) {
        if (n_in != 21 || ws_size < WS_NEED) { fprintf(stderr, "kernel_launch: unexpected inputs (n_in %d, ws %zu)\n", n_in, ws_size); grid = -1; return; }
        int dev = 0, cus = 0, per_cu = 0;
        hipGetDevice(&dev);
        hipDeviceGetAttribute(&cus, hipDeviceAttributeMultiprocessorCount, dev);
        if (hipFuncSetAttribute((const void*)fwd_megakernel, hipFuncAttributeMaxDynamicSharedMemorySize, LDS_BYTES) != hipSuccess) { fprintf(stderr, "kernel_launch: hipFuncSetAttribute failed\n"); grid = -1; return; }
        if (hipOccupancyMaxActiveBlocksPerMultiprocessor(&per_cu, (const void*)fwd_megakernel, NWAVES * 64, LDS_BYTES) != hipSuccess || per_cu < 1) { fprintf(stderr, "kernel_launch: occupancy query gave %d\n", per_cu); per_cu = 1; }
        (void)hipGetLastError();
        grid = cus * per_cu;
        if (grid > 256) grid = 256;
    }
    if (grid < 0) return;
    (void)hipMemsetAsync((char*)d_ws + WS_BAR, 0, 16384, stream);
    Args a{};
    for (int i = 0; i < 21; ++i) a.in[i] = (const float*)d_in[i];
    a.out = (float*)d_out; a.ws = (unsigned char*)d_ws;
    void* kargs[] = {&a};
    hipError_t e = hipLaunchCooperativeKernel((const void*)fwd_megakernel, dim3(grid), dim3(NWAVES * 64), kargs, LDS_BYTES, stream);
    if (e != hipSuccess) fprintf(stderr, "cooperative launch failed: %s (grid %d)\n", hipGetErrorString(e), grid);
}
```
